# Optimizing an MI355X kernel written in HIP

```python
import jax, jax.numpy as jnp
from jax import lax
import numpy as np

D_MODEL = 1024
BATCH = 4
SEQ = 4096
DEPTH = 4

HEAD_DIM = 64
N_HEADS = D_MODEL // HEAD_DIM
N_HEADS_MOBA = N_HEADS // 2
N_HEADS_DIL = N_HEADS - N_HEADS_MOBA
D_MOBA = N_HEADS_MOBA * HEAD_DIM
D_DIL = N_HEADS_DIL * HEAD_DIM
D_FF = 4 * D_MODEL
MOBA_BLOCK = 256
MOBA_TOPK = 3
MOBA_Q_BLOCK = 32
DILATED_CONFIGS = ((128, 1), (512, 4), (2048, 16))
DIL_Q_BLOCK = 64
ROPE_THETA = 10000.0
NORM_EPS = 1e-6
NEG_INF = -1e30

kernel_name = "hymba_moba_dilated_hybrid"


def rms_norm(x, g):
    xf = x.astype(jnp.float32)
    y = xf * lax.rsqrt(jnp.mean(xf * xf, axis=-1, keepdims=True) + NORM_EPS)
    return (y * g.astype(jnp.float32)).astype(x.dtype)


def rope_tables(seq):
    inv = 1.0 / (ROPE_THETA ** (jnp.arange(0, HEAD_DIM, 2, dtype=jnp.float32) / HEAD_DIM))
    ang = jnp.arange(seq, dtype=jnp.float32)[:, None] * inv[None, :]
    return jnp.cos(ang), jnp.sin(ang)


def apply_rope(x, cos, sin):
    x1, x2 = jnp.split(x.astype(jnp.float32), 2, axis=-1)
    out = jnp.concatenate([x1 * cos - x2 * sin, x2 * cos + x1 * sin], axis=-1)
    return out.astype(x.dtype)


def split_heads(t, n_heads):
    b, s, _ = t.shape
    return t.reshape(b, s, n_heads, HEAD_DIM).transpose(0, 2, 1, 3)


def merge_heads(t):
    b, h, s, hd = t.shape
    return t.transpose(0, 2, 1, 3).reshape(b, s, h * hd)


def moba_attention(q, k, v):
    b, h, s, hd = q.shape
    nb = -(-s // MOBA_BLOCK)
    pad = nb * MOBA_BLOCK - s
    k_blocks = jnp.pad(k, ((0, 0), (0, 0), (0, pad), (0, 0))).reshape(b, h, nb, MOBA_BLOCK, hd)
    v_blocks = jnp.pad(v, ((0, 0), (0, 0), (0, pad), (0, 0))).reshape(b, h, nb, MOBA_BLOCK, hd)
    k_mean = jnp.mean(k_blocks.astype(jnp.float32), axis=3)
    q_block_id = jnp.arange(s) // MOBA_BLOCK
    gate = jnp.einsum('bhsd,bhnd->bhsn', q.astype(jnp.float32), k_mean)
    past = jnp.arange(nb)[None, :] < q_block_id[:, None]
    gate = jnp.where(past, gate, NEG_INF)
    topk = min(MOBA_TOPK, nb)
    _, sel = lax.top_k(gate, topk)
    sel_valid = sel < q_block_id[:, None]
    gather_blocks = jax.vmap(jax.vmap(lambda blocks, idx: blocks[idx]))
    scale = HEAD_DIM ** -0.5

    def one_block(start):
        qb = lax.dynamic_slice_in_dim(q, start, MOBA_Q_BLOCK, axis=2)
        selb = lax.dynamic_slice_in_dim(sel, start, MOBA_Q_BLOCK, axis=2)
        validb = lax.dynamic_slice_in_dim(sel_valid, start, MOBA_Q_BLOCK, axis=2)
        t = start + jnp.arange(MOBA_Q_BLOCK)
        own = start // MOBA_BLOCK
        k_own = lax.dynamic_index_in_dim(k_blocks, own, axis=2, keepdims=False)
        v_own = lax.dynamic_index_in_dim(v_blocks, own, axis=2, keepdims=False)
        k_sel = gather_blocks(k_blocks, selb)
        v_sel = gather_blocks(v_blocks, selb)
        s_sel = jnp.einsum('bhqd,bhqkjd->bhqkj', qb, k_sel).astype(jnp.float32) * scale
        s_sel = jnp.where(validb[..., None], s_sel, NEG_INF).reshape(b, h, MOBA_Q_BLOCK, topk * MOBA_BLOCK)
        s_own = jnp.einsum('bhqd,bhjd->bhqj', qb, k_own).astype(jnp.float32) * scale
        own_pos = own * MOBA_BLOCK + jnp.arange(MOBA_BLOCK)
        s_own = jnp.where(own_pos[None, :] <= t[:, None], s_own, NEG_INF)
        p = jax.nn.softmax(jnp.concatenate([s_sel, s_own], axis=-1), axis=-1).astype(v.dtype)
        p_sel = p[..., :topk * MOBA_BLOCK].reshape(b, h, MOBA_Q_BLOCK, topk, MOBA_BLOCK)
        p_own = p[..., topk * MOBA_BLOCK:]
        return (jnp.einsum('bhqkj,bhqkjd->bhqd', p_sel, v_sel)
                + jnp.einsum('bhqj,bhjd->bhqd', p_own, v_own))

    starts = jnp.arange(s // MOBA_Q_BLOCK) * MOBA_Q_BLOCK
    out = lax.map(one_block, starts)
    return jnp.moveaxis(out, 0, 2).reshape(b, h, s, hd)


def dilated_attention(q, k, v):
    b, h, s, hd = q.shape
    scale = HEAD_DIM ** -0.5

    def one_block(start):
        qb = lax.dynamic_slice_in_dim(q, start, DIL_Q_BLOCK, axis=2)
        t = start + jnp.arange(DIL_Q_BLOCK)
        outs, lses = [], []
        for window, dilation in DILATED_CONFIGS:
            n_keys = window // dilation + 1
            idx = t[:, None] - dilation * jnp.arange(n_keys)[None, :]
            valid = idx >= 0
            idx = jnp.maximum(idx, 0)
            kg = jnp.take(k, idx, axis=2)
            vg = jnp.take(v, idx, axis=2)
            sc = jnp.einsum('bhqd,bhqnd->bhqn', qb, kg).astype(jnp.float32) * scale
            sc = jnp.where(valid, sc, NEG_INF)
            lse = jax.nn.logsumexp(sc, axis=-1)
            p = jnp.exp(sc - lse[..., None])
            outs.append(jnp.einsum('bhqn,bhqnd->bhqd', p, vg.astype(jnp.float32)))
            lses.append(lse)
        w = jax.nn.softmax(jnp.stack(lses, axis=0), axis=0)
        out = jnp.einsum('gbhq,gbhqd->bhqd', w, jnp.stack(outs, axis=0))
        return out.astype(v.dtype)

    starts = jnp.arange(s // DIL_Q_BLOCK) * DIL_Q_BLOCK
    out = lax.map(one_block, starts)
    return jnp.moveaxis(out, 0, 2).reshape(b, h, s, hd)


def hybrid_layer(x, attn_norm, w_in, moba_out_norm, dil_out_norm, w_out,
                 mlp_norm, w_up, w_down, cos, sin):
    h = rms_norm(x, attn_norm)
    proj = h @ w_in
    qa, ka, va, qd, kd, vd = jnp.split(
        proj, [D_MOBA, 2 * D_MOBA, 3 * D_MOBA, 3 * D_MOBA + D_DIL, 3 * D_MOBA + 2 * D_DIL], axis=-1)
    qa = apply_rope(split_heads(qa, N_HEADS_MOBA), cos, sin)
    ka = apply_rope(split_heads(ka, N_HEADS_MOBA), cos, sin)
    va = split_heads(va, N_HEADS_MOBA)
    qd = apply_rope(split_heads(qd, N_HEADS_DIL), cos, sin)
    kd = apply_rope(split_heads(kd, N_HEADS_DIL), cos, sin)
    vd = split_heads(vd, N_HEADS_DIL)
    out_a = rms_norm(merge_heads(moba_attention(qa, ka, va)), moba_out_norm)
    out_d = rms_norm(merge_heads(dilated_attention(qd, kd, vd)), dil_out_norm)
    x = x + jnp.concatenate([out_a, out_d], axis=-1) @ w_out
    h = rms_norm(x, mlp_norm)
    x = x + jnp.square(jax.nn.relu(h @ w_up)) @ w_down
    return x


def setup_inputs(seed: int = 0) -> dict:
    key = jax.random.key(seed)
    ks = jax.random.split(key, 10)
    f32 = jnp.float32
    return {
        "x": jax.random.normal(ks[0], (BATCH, SEQ, D_MODEL), f32),
        "attn_norm": 1.0 + 0.02 * jax.random.normal(ks[1], (DEPTH, D_MODEL), f32),
        "w_in": jax.random.normal(ks[2], (DEPTH, D_MODEL, 3 * D_MODEL), f32) * D_MODEL ** -0.5,
        "moba_out_norm": 1.0 + 0.02 * jax.random.normal(ks[3], (DEPTH, D_MOBA), f32),
        "dil_out_norm": 1.0 + 0.02 * jax.random.normal(ks[4], (DEPTH, D_DIL), f32),
        "w_out": jax.random.normal(ks[5], (DEPTH, D_MODEL, D_MODEL), f32) * (2 * D_MODEL) ** -0.5,
        "mlp_norm": 1.0 + 0.02 * jax.random.normal(ks[6], (DEPTH, D_MODEL), f32),
        "w_up": jax.random.normal(ks[7], (DEPTH, D_MODEL, D_FF), f32) * D_MODEL ** -0.5,
        "w_down": jax.random.normal(ks[8], (DEPTH, D_FF, D_MODEL), f32) * D_FF ** -0.5,
        "final_norm": 1.0 + 0.02 * jax.random.normal(ks[9], (D_MODEL,), f32),
    }


def reference(x, attn_norm, w_in, moba_out_norm, dil_out_norm, w_out,
              mlp_norm, w_up, w_down, final_norm):
    cos, sin = rope_tables(x.shape[1])
    for l in range(DEPTH):
        x = hybrid_layer(x, attn_norm[l], w_in[l], moba_out_norm[l], dil_out_norm[l], w_out[l],
                         mlp_norm[l], w_up[l], w_down[l], cos, sin)
    return rms_norm(x, final_norm)
```

```cpp
#include <hip/hip_runtime.h>
#include <stdint.h>
#include <cstdio>

namespace {
constexpr int BATCH = 4, SEQ = 4096, DM = 1024, DEPTH = 4, HD = 64, DFF = 4096, M = BATCH * SEQ, NQKV = 3072;
constexpr int NBLK = 16;
constexpr float EPS = 1e-6f;
typedef unsigned short bf16_t;

__device__ __forceinline__ unsigned f2bf(float f) { unsigned u = __builtin_bit_cast(unsigned, f); return (u + 0x7fffu + ((u >> 16) & 1u)) >> 16; }
__device__ __forceinline__ float bf2f(unsigned h) { return __builtin_bit_cast(float, h << 16); }
__device__ __forceinline__ float wave_sum(float v) {
#pragma unroll
    for (int o = 1; o < 64; o <<= 1) v += __shfl_xor(v, o);
    return v;
}
__device__ __forceinline__ float wave_max(float v) {
#pragma unroll
    for (int o = 1; o < 64; o <<= 1) v = fmaxf(v, __shfl_xor(v, o));
    return v;
}

__global__ void __launch_bounds__(256) rope_table_kernel(float* cs) {
    const int idx = blockIdx.x * 256 + threadIdx.x;
    if (idx >= SEQ * 32) return;
    const int t = idx >> 5, i = idx & 31;
    const float inv = 1.0f / powf(10000.0f, (float)(2 * i) / 64.0f);
    const float ang = (float)t * inv;
    cs[idx] = cosf(ang); cs[SEQ * 32 + idx] = sinf(ang);
}

__global__ void __launch_bounds__(256) rowstat_kernel(const float* x, bf16_t* xb, float* rs) {
    const int row = blockIdx.x * 4 + (threadIdx.x >> 6), lane = threadIdx.x & 63;
    const float4* xr = (const float4*)(x + (size_t)row * DM);
    float s = 0.f;
#pragma unroll
    for (int j = 0; j < 4; ++j) {
        const float4 v = xr[lane + 64 * j];
        s += v.x * v.x + v.y * v.y + v.z * v.z + v.w * v.w;
        uint2 o; o.x = f2bf(v.x) | (f2bf(v.y) << 16); o.y = f2bf(v.z) | (f2bf(v.w) << 16);
        ((uint2*)(xb + (size_t)row * DM))[lane + 64 * j] = o;
    }
    s = wave_sum(s);
    if (lane == 0) rs[row] = 1.0f / sqrtf(s * (1.0f / DM) + EPS);
}

template <int MODE>
__global__ void __launch_bounds__(256) gemm_naive(const bf16_t* __restrict__ A, const float* __restrict__ W, const float* __restrict__ gain,
                                                  int N, int K, const float* __restrict__ rs, const float* __restrict__ cs, bf16_t* outb, float* xres) {
    __shared__ float As[16][68];
    __shared__ float Bs[16][64];
    __shared__ float Cs[64][65];
    const int tid = threadIdx.x, tx = tid & 15, ty = tid >> 4;
    const int m0 = blockIdx.y * 64, n0 = blockIdx.x * 64;
    float acc[4][4];
#pragma unroll
    for (int i = 0; i < 4; ++i)
#pragma unroll
        for (int j = 0; j < 4; ++j) acc[i][j] = 0.f;
    const int ar = tid >> 2, akq = (tid & 3) * 4;
    const int bk = tid >> 4, bn = (tid & 15) * 4;
    for (int k0 = 0; k0 < K; k0 += 16) {
        const uint2 av = *(const uint2*)(A + (size_t)(m0 + ar) * K + k0 + akq);
        const float g = gain ? gain[k0 + bk] : 1.0f;
        const float4 bv = *(const float4*)(W + (size_t)(k0 + bk) * N + n0 + bn);
        __syncthreads();
        As[akq + 0][ar] = bf2f(av.x & 0xffffu); As[akq + 1][ar] = bf2f(av.x >> 16);
        As[akq + 2][ar] = bf2f(av.y & 0xffffu); As[akq + 3][ar] = bf2f(av.y >> 16);
        Bs[bk][bn + 0] = bv.x * g; Bs[bk][bn + 1] = bv.y * g; Bs[bk][bn + 2] = bv.z * g; Bs[bk][bn + 3] = bv.w * g;
        __syncthreads();
#pragma unroll
        for (int k = 0; k < 16; ++k) {
            const float4 a = *(const float4*)&As[k][ty * 4];
            const float4 b = *(const float4*)&Bs[k][tx * 4];
            const float aa[4] = {a.x, a.y, a.z, a.w}, bb[4] = {b.x, b.y, b.z, b.w};
#pragma unroll
            for (int i = 0; i < 4; ++i)
#pragma unroll
                for (int j = 0; j < 4; ++j) acc[i][j] += aa[i] * bb[j];
        }
    }
    if (MODE == 1) {
#pragma unroll
        for (int i = 0; i < 4; ++i) {
            float4* p = (float4*)(xres + (size_t)(m0 + ty * 4 + i) * N + n0 + tx * 4);
            float4 v = *p; v.x += acc[i][0]; v.y += acc[i][1]; v.z += acc[i][2]; v.w += acc[i][3]; *p = v;
        }
        return;
    }
#pragma unroll
    for (int i = 0; i < 4; ++i) {
        const float r = rs[m0 + ty * 4 + i];
#pragma unroll
        for (int j = 0; j < 4; ++j) Cs[ty * 4 + i][tx * 4 + j] = acc[i][j] * r;
    }
    __syncthreads();
    if (MODE == 0) {
        const bool rope = (n0 < 1024) || (n0 >= 1536 && n0 < 2560);
        for (int e = tid; e < 64 * 32; e += 256) {
            const int r = e >> 5, d = e & 31, m = m0 + r, t = m & (SEQ - 1);
            float x1 = Cs[r][d], x2 = Cs[r][d + 32], o1 = x1, o2 = x2;
            if (rope) { const float c = cs[t * 32 + d], s = cs[SEQ * 32 + t * 32 + d]; o1 = x1 * c - x2 * s; o2 = x2 * c + x1 * s; }
            outb[(size_t)m * N + n0 + d] = (bf16_t)f2bf(o1); outb[(size_t)m * N + n0 + d + 32] = (bf16_t)f2bf(o2);
        }
    } else {
        for (int e = tid; e < 64 * 64; e += 256) {
            const int r = e >> 6, c = e & 63; float v = Cs[r][c]; v = v > 0.f ? v * v : 0.f;
            outb[(size_t)(m0 + r) * N + n0 + c] = (bf16_t)f2bf(v);
        }
    }
}

__global__ void __launch_bounds__(64) kmean_kernel(const bf16_t* qkv, float* kmean) {
    const int id = blockIdx.x, j = id & 15, h = (id >> 4) & 7, b = id >> 7, d = threadIdx.x;
    const bf16_t* kp = qkv + (size_t)(b * SEQ + j * 256) * NQKV + 512 + h * 64 + d;
    float s = 0.f;
    for (int r = 0; r < 256; ++r) s += bf2f(kp[(size_t)r * NQKV]);
    kmean[(size_t)id * 64 + d] = s * (1.0f / 256.0f);
}

#define KEY_UPDATE(krow, vrow, valid)                                                                                   \
    do {                                                                                                                \
        if (valid) {                                                                                                    \
            float s = 0.f;                                                                                              \
            _Pragma("unroll") for (int c = 0; c < 8; ++c) {                                                             \
                const uint4 kk = ((const uint4*)(krow))[c];                                                             \
                s += qv[8 * c + 0] * bf2f(kk.x & 0xffffu) + qv[8 * c + 1] * bf2f(kk.x >> 16) + qv[8 * c + 2] * bf2f(kk.y & 0xffffu) + qv[8 * c + 3] * bf2f(kk.y >> 16) \
                   + qv[8 * c + 4] * bf2f(kk.z & 0xffffu) + qv[8 * c + 5] * bf2f(kk.z >> 16) + qv[8 * c + 6] * bf2f(kk.w & 0xffffu) + qv[8 * c + 7] * bf2f(kk.w >> 16); \
            }                                                                                                           \
            s *= 0.125f;                                                                                                \
            if (s > mrun) { const float f = __expf(mrun - s); lrun *= f; _Pragma("unroll") for (int d = 0; d < 64; ++d) ov[d] *= f; mrun = s; } \
            const float p = __expf(s - mrun); lrun += p;                                                                \
            _Pragma("unroll") for (int c = 0; c < 8; ++c) {                                                             \
                const uint4 vv = ((const uint4*)(vrow))[c];                                                             \
                ov[8 * c + 0] += p * bf2f(vv.x & 0xffffu); ov[8 * c + 1] += p * bf2f(vv.x >> 16); ov[8 * c + 2] += p * bf2f(vv.y & 0xffffu); ov[8 * c + 3] += p * bf2f(vv.y >> 16); \
                ov[8 * c + 4] += p * bf2f(vv.z & 0xffffu); ov[8 * c + 5] += p * bf2f(vv.z >> 16); ov[8 * c + 6] += p * bf2f(vv.w & 0xffffu); ov[8 * c + 7] += p * bf2f(vv.w >> 16); \
            }                                                                                                           \
        }                                                                                                               \
    } while (0)

#define WAVE_FINISH(orow, ssptr)                                                                                        \
    do {                                                                                                                \
        const float mall = wave_max(mrun);                                                                              \
        const float f = (mrun > -1e37f) ? __expf(mrun - mall) : 0.f;                                                    \
        const float ltot = wave_sum(lrun * f); const float il = 1.0f / ltot;                                            \
        float mine = 0.f, sq = 0.f;                                                                                     \
        _Pragma("unroll") for (int d = 0; d < 64; ++d) { const float od = wave_sum(ov[d] * f) * il; sq += od * od; if (lane == d) mine = od; } \
        (orow)[lane] = (bf16_t)f2bf(mine);                                                                              \
        if (lane == 0) *(ssptr) = sq;                                                                                   \
    } while (0)

__global__ void __launch_bounds__(256) moba_naive(const bf16_t* __restrict__ qkv, const float* __restrict__ kmean, bf16_t* ao, float* ss) {
    const int w = blockIdx.x * 4 + (threadIdx.x >> 6), lane = threadIdx.x & 63;
    const int t = w & (SEQ - 1), h = (w >> 12) & 7, b = w >> 15, m = b * SEQ + t, qb = t >> 8;
    float qv[64];
    {
        const uint4* qp = (const uint4*)(qkv + (size_t)m * NQKV + h * 64);
#pragma unroll
        for (int c = 0; c < 8; ++c) { const uint4 u = qp[c];
            qv[8 * c + 0] = bf2f(u.x & 0xffffu); qv[8 * c + 1] = bf2f(u.x >> 16); qv[8 * c + 2] = bf2f(u.y & 0xffffu); qv[8 * c + 3] = bf2f(u.y >> 16);
            qv[8 * c + 4] = bf2f(u.z & 0xffffu); qv[8 * c + 5] = bf2f(u.z >> 16); qv[8 * c + 6] = bf2f(u.w & 0xffffu); qv[8 * c + 7] = bf2f(u.w >> 16); }
    }
    float gj;
    {
        const int j = lane & 15; const float4* kmp = (const float4*)(kmean + (size_t)((b * 8 + h) * 16 + j) * 64);
        float s = 0.f;
#pragma unroll
        for (int c = 0; c < 16; ++c) { const float4 k4 = kmp[c]; s += qv[4 * c] * k4.x + qv[4 * c + 1] * k4.y + qv[4 * c + 2] * k4.z + qv[4 * c + 3] * k4.w; }
        gj = (j < qb) ? s : -1e30f;
    }
    unsigned sel = 0u;
#pragma unroll
    for (int r = 0; r < 3; ++r) {
        float best = -INFINITY; int bi = 0;
#pragma unroll
        for (int jj = 0; jj < 16; ++jj) { const float v = __shfl(gj, jj); const bool ok = !((sel >> jj) & 1u); if (ok && v > best) { best = v; bi = jj; } }
        sel |= 1u << bi;
    }
    sel &= (1u << qb) - 1u;
    sel |= 1u << qb;
    float ov[64]; float mrun = -INFINITY, lrun = 0.f;
#pragma unroll
    for (int d = 0; d < 64; ++d) ov[d] = 0.f;
    const bf16_t* kbase = qkv + (size_t)(b * SEQ) * NQKV + 512 + h * 64;
    const bf16_t* vbase = qkv + (size_t)(b * SEQ) * NQKV + 1024 + h * 64;
    for (int jb = 0; jb <= qb; ++jb) {
        if (!((sel >> jb) & 1u)) continue;
        for (int i = 0; i < 4; ++i) {
            const int key = jb * 256 + i * 64 + lane;
            const bool valid = key <= t;
            KEY_UPDATE(kbase + (size_t)key * NQKV, vbase + (size_t)key * NQKV, valid);
        }
    }
    WAVE_FINISH(ao + (size_t)m * DM + h * 64, ss + (size_t)m * 16 + h);
}

__global__ void __launch_bounds__(256) dil_naive(const bf16_t* __restrict__ qkv, bf16_t* ao, float* ss) {
    const int w = blockIdx.x * 4 + (threadIdx.x >> 6), lane = threadIdx.x & 63;
    const int t = w & (SEQ - 1), h = (w >> 12) & 7, b = w >> 15, m = b * SEQ + t;
    float qv[64];
    {
        const uint4* qp = (const uint4*)(qkv + (size_t)m * NQKV + 1536 + h * 64);
#pragma unroll
        for (int c = 0; c < 8; ++c) { const uint4 u = qp[c];
            qv[8 * c + 0] = bf2f(u.x & 0xffffu); qv[8 * c + 1] = bf2f(u.x >> 16); qv[8 * c + 2] = bf2f(u.y & 0xffffu); qv[8 * c + 3] = bf2f(u.y >> 16);
            qv[8 * c + 4] = bf2f(u.z & 0xffffu); qv[8 * c + 5] = bf2f(u.z >> 16); qv[8 * c + 6] = bf2f(u.w & 0xffffu); qv[8 * c + 7] = bf2f(u.w >> 16); }
    }
    float ov[64]; float mrun = -INFINITY, lrun = 0.f;
#pragma unroll
    for (int d = 0; d < 64; ++d) ov[d] = 0.f;
    const bf16_t* kbase = qkv + (size_t)(b * SEQ) * NQKV + 2048 + h * 64;
    const bf16_t* vbase = qkv + (size_t)(b * SEQ) * NQKV + 2560 + h * 64;
    for (int cfg = 0; cfg < 3; ++cfg) {
        const int dil = cfg == 0 ? 1 : (cfg == 1 ? 4 : 16);
        for (int i = 0; i < 3; ++i) {
            const int n = i * 64 + lane; const int key = t - dil * n;
            const bool valid = (n < 129) && (key >= 0);
            const int keyc = key < 0 ? 0 : key;
            KEY_UPDATE(kbase + (size_t)keyc * NQKV, vbase + (size_t)keyc * NQKV, valid);
        }
    }
    WAVE_FINISH(ao + (size_t)m * DM + 512 + h * 64, ss + (size_t)m * 16 + 8 + h);
}

__global__ void __launch_bounds__(256) outnorm_kernel(const bf16_t* ao, const float* ss, const float* ga, const float* gd, bf16_t* cat) {
    const int row = blockIdx.x * 4 + (threadIdx.x >> 6), lane = threadIdx.x & 63;
    float sa = 0.f, sd = 0.f;
#pragma unroll
    for (int h = 0; h < 8; ++h) { sa += ss[(size_t)row * 16 + h]; sd += ss[(size_t)row * 16 + 8 + h]; }
    const float ra = 1.0f / sqrtf(sa * (1.0f / 512.0f) + EPS), rd = 1.0f / sqrtf(sd * (1.0f / 512.0f) + EPS);
#pragma unroll
    for (int j = 0; j < 4; ++j) {
        const int c0 = (lane + 64 * j) * 4;
        const uint2 u = *(const uint2*)(ao + (size_t)row * DM + c0);
        const float r = c0 < 512 ? ra : rd; const float* g = c0 < 512 ? ga + c0 : gd + (c0 - 512);
        const float v0 = bf2f(u.x & 0xffffu) * r * g[0], v1 = bf2f(u.x >> 16) * r * g[1], v2 = bf2f(u.y & 0xffffu) * r * g[2], v3 = bf2f(u.y >> 16) * r * g[3];
        uint2 o; o.x = f2bf(v0) | (f2bf(v1) << 16); o.y = f2bf(v2) | (f2bf(v3) << 16);
        *(uint2*)(cat + (size_t)row * DM + c0) = o;
    }
}

__global__ void __launch_bounds__(256) finalnorm_kernel(float* x, const float* g) {
    const int row = blockIdx.x * 4 + (threadIdx.x >> 6), lane = threadIdx.x & 63;
    float4* xr = (float4*)(x + (size_t)row * DM);
    float4 v[4]; float s = 0.f;
#pragma unroll
    for (int j = 0; j < 4; ++j) { v[j] = xr[lane + 64 * j]; s += v[j].x * v[j].x + v[j].y * v[j].y + v[j].z * v[j].z + v[j].w * v[j].w; }
    s = wave_sum(s);
    const float r = 1.0f / sqrtf(s * (1.0f / DM) + EPS);
#pragma unroll
    for (int j = 0; j < 4; ++j) { const float4 gg = ((const float4*)g)[lane + 64 * j];
        float4 o; o.x = v[j].x * r * gg.x; o.y = v[j].y * r * gg.y; o.z = v[j].z * r * gg.z; o.w = v[j].w * r * gg.w; xr[lane + 64 * j] = o; }
}
}

extern "C" void kernel_launch(void* const* d_in, const int* in_sizes, int n_in, void* d_out, int out_size, void* d_ws, size_t ws_size, hipStream_t stream) {
    constexpr size_t MiB = 1u << 20;
    const float* x = (const float*)d_in[0];
    const float* attn_norm = (const float*)d_in[1];
    const float* w_in = (const float*)d_in[2];
    const float* moba_norm = (const float*)d_in[3];
    const float* dil_norm = (const float*)d_in[4];
    const float* w_out = (const float*)d_in[5];
    const float* mlp_norm = (const float*)d_in[6];
    const float* w_up = (const float*)d_in[7];
    const float* w_down = (const float*)d_in[8];
    const float* final_norm = (const float*)d_in[9];
    float* xres = (float*)d_out;
    unsigned char* ws = (unsigned char*)d_ws;
    if (ws_size < 200 * MiB) { fprintf(stderr, "workspace too small\n"); return; }
    float* cs = (float*)(ws + 0);
    float* rs = (float*)(ws + 1 * MiB);
    float* ss = (float*)(ws + 2 * MiB);
    float* kmean = (float*)(ws + 3 * MiB);
    bf16_t* xb = (bf16_t*)(ws + 4 * MiB);
    bf16_t* qkv = (bf16_t*)(ws + 36 * MiB);
    bf16_t* ao = (bf16_t*)(ws + 132 * MiB);
    bf16_t* cat = (bf16_t*)(ws + 164 * MiB);
    bf16_t* hid = (bf16_t*)(ws + 36 * MiB);

    hipMemcpyAsync(xres, x, (size_t)M * DM * 4, hipMemcpyDeviceToDevice, stream);
    rope_table_kernel<<<SEQ * 32 / 256, 256, 0, stream>>>(cs);
    for (int l = 0; l < DEPTH; ++l) {
        rowstat_kernel<<<M / 4, 256, 0, stream>>>(xres, xb, rs);
        gemm_naive<0><<<dim3(NQKV / 64, M / 64), 256, 0, stream>>>(xb, w_in + (size_t)l * DM * NQKV, attn_norm + l * DM, NQKV, DM, rs, cs, qkv, nullptr);
        kmean_kernel<<<BATCH * 8 * NBLK, 64, 0, stream>>>(qkv, kmean);
        moba_naive<<<BATCH * 8 * SEQ / 4, 256, 0, stream>>>(qkv, kmean, ao, ss);
        dil_naive<<<BATCH * 8 * SEQ / 4, 256, 0, stream>>>(qkv, ao, ss);
        outnorm_kernel<<<M / 4, 256, 0, stream>>>(ao, ss, moba_norm + l * 512, dil_norm + l * 512, cat);
        gemm_naive<1><<<dim3(DM / 64, M / 64), 256, 0, stream>>>(cat, w_out + (size_t)l * DM * DM, nullptr, DM, DM, nullptr, nullptr, nullptr, xres);
        rowstat_kernel<<<M / 4, 256, 0, stream>>>(xres, xb, rs);
        gemm_naive<2><<<dim3(DFF / 64, M / 64), 256, 0, stream>>>(xb, w_up + (size_t)l * DM * DFF, mlp_norm + l * DM, DFF, DM, rs, nullptr, hid, nullptr);
        gemm_naive<1><<<dim3(DM / 64, M / 64), 256, 0, stream>>>(hid, w_down + (size_t)l * DFF * DM, nullptr, DM, DFF, nullptr, nullptr, nullptr, xres);
    }
    finalnorm_kernel<<<M / 4, 256, 0, stream>>>(xres, final_norm);
}
```

```cpp
#include <hip/hip_runtime.h>
#include <cstdio>
#include <cstdint>

#ifndef MK_PER_PHASE
#define MK_PER_PHASE 0
#endif

constexpr int BATCH = 4, SEQ = 4096, DM = 1024, DEPTH = 4, DFF = 4096, M = BATCH * SEQ, NQKV = 3072;
constexpr float NORM_EPS = 1e-6f;
constexpr float C2 = 0.125f * 1.4426950408889634f;

namespace pg8 {
#define PG8_LAS __attribute__((address_space(3)))
typedef unsigned short bf16_t;
typedef short bf16x8 __attribute__((ext_vector_type(8)));
typedef float f32x4 __attribute__((ext_vector_type(4)));
typedef unsigned u32x4 __attribute__((ext_vector_type(4)));
#define PG8_GAS __attribute__((address_space(1)))
typedef PG8_GAS float gf32; typedef PG8_GAS const float gcf32; typedef PG8_GAS bf16_t gbf16;
typedef PG8_GAS f32x4 gf32x4; typedef PG8_GAS const f32x4 gcf32x4; typedef PG8_GAS u32x4 gu32x4;
constexpr int BM = 256, BK = 64, HALF = 128, HTB = HALF * BK * 2, STAGE_BYTES = 8 * HTB, NXCD = 8, WGM = 8;

__host__ __device__ __forceinline__ int lds_byte(int r, int c) { const int st = (r >> 4) * 2 + (c >> 5), rr = r & 15, cc = c & 31, ob = rr * 64 + cc * 2; return st * 1024 + (ob ^ (((ob >> 9) & 1) << 5)); }
__host__ __device__ __forceinline__ void stage_rc(int b, int& R, int& C) { const int st = b / 1024, sb = b % 1024, swz = sb ^ (((sb >> 9) & 1) << 5); R = (st >> 1) * 16 + swz / 64; C = (st & 1) * 32 + (swz % 64) / 2; }
__host__ __device__ __forceinline__ int perm32(int rho) { const int n = rho >> 4, i = rho & 15; return 8 * (i >> 2) + 4 * n + (i & 3); }

struct Unit { int pm, pn; };
struct Gemm { const bf16_t* A; const bf16_t* Bt; int M, N, K; };

struct StaticOrder {
    int nM, nN, nwg, G, c;
    __host__ __device__ void init(int M_, int N_, int G_, int c_) { nM = M_ / BM; nN = N_ / BM; nwg = nM * nN; G = G_; c = c_; }
    __host__ __device__ bool next(int i, Unit& u) const {
        const long L = (long)i * G + c; if (L >= nwg) return false;
        int wgid = (int)L; { const int q = nwg / NXCD, r = nwg % NXCD, xcd = wgid % NXCD, off = wgid / NXCD; wgid = (xcd < r ? xcd * (q + 1) : r * (q + 1) + (xcd - r) * q) + off; }
        const int nig = WGM * nN, gid = wgid / nig, fm = gid * WGM, gsz = (nM - fm) < WGM ? (nM - fm) : WGM;
        u.pm = fm + ((wgid % nig) % gsz); u.pn = (wgid % nig) / gsz; return true;
    }
    __device__ __forceinline__ void a_ready(const Unit&) const {}
    __device__ __forceinline__ void done(const Unit&) const {}
};

__device__ __forceinline__ unsigned cvt_pk_bf16(float lo, float hi) { unsigned r; asm volatile("v_cvt_pk_bf16_f32 %0, %1, %2" : "=v"(r) : "v"(lo), "v"(hi)); return r; }

__device__ __forceinline__ int lane_id_now() { int l; asm volatile("v_mbcnt_lo_u32_b32 %0, -1, 0\n\tv_mbcnt_hi_u32_b32 %0, -1, %0" : "=v"(l)); return l; }
#define PG8_FRESH_LANE() const int lane_f = lane_id_now(), fr = lane_f & 15, fq = lane_f >> 4
__device__ __forceinline__ float row_rs(gcf32* stats, int row, float inv_n) {
    gcf32x4* p = (gcf32x4*)(stats + (size_t)row * 16);
    const f32x4 a = p[0], b = p[1], c = p[2], d = p[3];
    const float s = ((a[0] + a[1]) + (a[2] + a[3])) + ((b[0] + b[1]) + (b[2] + b[3])) + ((c[0] + c[1]) + (c[2] + c[3])) + ((d[0] + d[1]) + (d[2] + d[3]));
    return 1.0f / sqrtf(s * inv_n + NORM_EPS);
}


struct EpiQKV {
    static constexpr bool PERM = true, AFTER_DRAIN = false, MID = false;
    gbf16* Q; size_t arr_stride; gcf32* stats; gcf32* cs;
    __device__ __forceinline__ void mid(f32x4 (&)[2][2][4][2], const Unit&, int, int, int, int) const {}
    __device__ __forceinline__ void operator()(const f32x4 (&acc)[2][2][4][2], const Unit& u, int wr, int wc, int, int) const {
        PG8_FRESH_LANE();
        const int arr = u.pn >> 2;
        gbf16* base = Q + (size_t)arr * arr_stride;
        const int col0 = (u.pn & 3) * 256 + 64 * wc + 8 * fq;
        const float qs = arr == 0 ? C2 : 1.0f;
#pragma unroll
        for (int ai = 0; ai < 2; ++ai)
#pragma unroll
            for (int m = 0; m < 4; ++m) {
                const int row = u.pm * BM + ai * HALF + wr * 64 + m * 16 + fr;
                const float rs = row_rs(stats, row, 1.0f / DM) * qs;
                f32x4 l0 = acc[ai][0][m][0] * rs, l1 = acc[ai][0][m][1] * rs, h0 = acc[ai][1][m][0] * rs, h1 = acc[ai][1][m][1] * rs;
                if (arr < 2) {
                    const int t = row & (SEQ - 1);
                    const f32x4 c0 = *(gcf32x4*)(cs + t * 32 + 8 * fq), c1 = *(gcf32x4*)(cs + t * 32 + 8 * fq + 4);
                    const f32x4 s0 = *(gcf32x4*)(cs + SEQ * 32 + t * 32 + 8 * fq), s1 = *(gcf32x4*)(cs + SEQ * 32 + t * 32 + 8 * fq + 4);
                    const f32x4 o0 = l0 * c0 - h0 * s0, o1 = l1 * c1 - h1 * s1, p0 = h0 * c0 + l0 * s0, p1 = h1 * c1 + l1 * s1;
                    l0 = o0; l1 = o1; h0 = p0; h1 = p1;
                }
                gbf16* rowp = base + (size_t)row * DM + col0;
                u32x4 w; w.x = cvt_pk_bf16(l0[0], l0[1]); w.y = cvt_pk_bf16(l0[2], l0[3]); w.z = cvt_pk_bf16(l1[0], l1[1]); w.w = cvt_pk_bf16(l1[2], l1[3]);
                *(gu32x4*)rowp = w;
                w.x = cvt_pk_bf16(h0[0], h0[1]); w.y = cvt_pk_bf16(h0[2], h0[3]); w.z = cvt_pk_bf16(h1[0], h1[1]); w.w = cvt_pk_bf16(h1[2], h1[3]);
                *(gu32x4*)(rowp + 32) = w;
                if (m & 1) asm volatile("" ::: "memory");
            }
    }
};

struct EpiUp {
    static constexpr bool PERM = true, AFTER_DRAIN = false, MID = false;
    gbf16* H; gcf32* stats;
    __device__ __forceinline__ void mid(f32x4 (&)[2][2][4][2], const Unit&, int, int, int, int) const {}
    __device__ __forceinline__ void operator()(const f32x4 (&acc)[2][2][4][2], const Unit& u, int wr, int wc, int, int) const {
        PG8_FRESH_LANE();
        const int col0 = u.pn * BM + wc * 32 + 8 * fq;
#pragma unroll
        for (int ai = 0; ai < 2; ++ai)
#pragma unroll
            for (int m = 0; m < 4; ++m) {
                const int row = u.pm * BM + ai * HALF + wr * 64 + m * 16 + fr;
                const float rs = row_rs(stats, row, 1.0f / DM);
                gbf16* rowp = H + (size_t)row * DFF + col0;
#pragma unroll
                for (int bj = 0; bj < 2; ++bj) {
                    f32x4 v0 = acc[ai][bj][m][0] * rs, v1 = acc[ai][bj][m][1] * rs;
#pragma unroll
                    for (int i = 0; i < 4; ++i) { const float a = fmaxf(v0[i], 0.f), b = fmaxf(v1[i], 0.f); v0[i] = a * a; v1[i] = b * b; }
                    u32x4 w; w.x = cvt_pk_bf16(v0[0], v0[1]); w.y = cvt_pk_bf16(v0[2], v0[3]); w.z = cvt_pk_bf16(v1[0], v1[1]); w.w = cvt_pk_bf16(v1[2], v1[3]);
                    *(gu32x4*)(rowp + bj * HALF) = w;
                }
                if (m & 1) asm volatile("" ::: "memory");
            }
    }
};

template <bool TWO_SCALE> struct EpiRes {
    static constexpr bool PERM = true, AFTER_DRAIN = false, MID = TWO_SCALE;
    gcf32* base; gf32* out; gbf16* xb; gf32* stats_out; gcf32* ss;
    __device__ __forceinline__ void half_scales(int row, float& ra, float& rd) const {
        gcf32x4* p = (gcf32x4*)(ss + (size_t)row * 16);
        const f32x4 a = p[0], b = p[1], c = p[2], d = p[3];
        const float sa = ((a[0] + a[1]) + (a[2] + a[3])) + ((b[0] + b[1]) + (b[2] + b[3])), sd = ((c[0] + c[1]) + (c[2] + c[3])) + ((d[0] + d[1]) + (d[2] + d[3]));
        ra = 1.0f / sqrtf(sa * (1.0f / 512.0f) + NORM_EPS); rd = 1.0f / sqrtf(sd * (1.0f / 512.0f) + NORM_EPS);
    }
    __device__ __forceinline__ void mid(f32x4 (&acc)[2][2][4][2], const Unit& u, int wr, int wc, int, int) const {
        if constexpr (TWO_SCALE) {
            PG8_FRESH_LANE(); (void)fq;
#pragma unroll
            for (int ai = 0; ai < 2; ++ai)
#pragma unroll
                for (int m = 0; m < 4; ++m) {
                    const int row = u.pm * BM + ai * HALF + wr * 64 + m * 16 + fr; float ra, rd; half_scales(row, ra, rd); const float f = ra / rd;
#pragma unroll
                    for (int bj = 0; bj < 2; ++bj)
#pragma unroll
                        for (int n = 0; n < 2; ++n) acc[ai][bj][m][n] = acc[ai][bj][m][n] * f;
                    if (m & 1) asm volatile("" ::: "memory");
                }
        }
    }
    __device__ __forceinline__ void operator()(const f32x4 (&acc)[2][2][4][2], const Unit& u, int wr, int wc, int, int) const {
        PG8_FRESH_LANE();
        const int col0 = u.pn * BM + wc * 32 + 8 * fq;
#pragma unroll
        for (int ai = 0; ai < 2; ++ai)
#pragma unroll
            for (int m = 0; m < 4; ++m) {
                const int row = u.pm * BM + ai * HALF + wr * 64 + m * 16 + fr;
                float rd = 1.0f; if constexpr (TWO_SCALE) { float ra; half_scales(row, ra, rd); }
                const size_t off = (size_t)row * DM + col0; float sq = 0.f;
#pragma unroll
                for (int bj = 0; bj < 2; ++bj) {
                    const f32x4 b0 = *(gcf32x4*)(base + off + bj * HALF), b1 = *(gcf32x4*)(base + off + bj * HALF + 4);
                    const f32x4 x0 = b0 + acc[ai][bj][m][0] * rd, x1 = b1 + acc[ai][bj][m][1] * rd;
                    *(gf32x4*)(out + off + bj * HALF) = x0; *(gf32x4*)(out + off + bj * HALF + 4) = x1;
                    sq += ((x0[0] * x0[0] + x0[1] * x0[1]) + (x0[2] * x0[2] + x0[3] * x0[3])) + ((x1[0] * x1[0] + x1[1] * x1[1]) + (x1[2] * x1[2] + x1[3] * x1[3]));
                    u32x4 w; w.x = cvt_pk_bf16(x0[0], x0[1]); w.y = cvt_pk_bf16(x0[2], x0[3]); w.z = cvt_pk_bf16(x1[0], x1[1]); w.w = cvt_pk_bf16(x1[2], x1[3]);
                    *(gu32x4*)(xb + off + bj * HALF) = w;
                }
                sq += __shfl_xor(sq, 16); sq += __shfl_xor(sq, 32);
                if (fq == 0) stats_out[(size_t)row * 16 + u.pn * 4 + wc] = sq;
                asm volatile("" ::: "memory");
            }
    }
};

template <class Epi, class Sched, bool ALIGN_EPI>
__device__ __forceinline__ void gemm_phase(PG8_LAS unsigned char* lds, const Gemm g, const Sched& S, const Epi& E, const int wid_  ) {
    int lane_; asm volatile("v_mbcnt_lo_u32_b32 %0, -1, 0\n\tv_mbcnt_hi_u32_b32 %0, -1, %0" : "=v"(lane_));
    const int lane = lane_, wid = wid_, tid = wid * 64 + lane, wr = wid >> 2, wc = wid & 3, fr = lane & 15, fq = lane >> 4;
    const int K = g.K, nt = K / BK;
    unsigned voffA[2], voffB[2];
#pragma unroll
    for (int i = 0; i < 2; ++i) { int R, C; stage_rc(tid * 16 + i * 8192, R, C); const int Rb = Epi::PERM ? ((R & ~31) + perm32(R & 31)) : R;
        voffA[i] = (unsigned)(R * K + C) * 2u; voffB[i] = (unsigned)(Rb * K + C) * 2u; }
    const size_t kstep = (size_t)(BK * 2);
    const size_t hstep = (size_t)HALF * K * 2;
    const size_t tstep = 2 * hstep;
    const unsigned ldsw = (unsigned)wid * 1024u;
    const int aoff = lds_byte(wr * 64 + fr, fq * 8), boff = lds_byte(wc * 32 + fr, fq * 8);
#define PG8_SA(b, h) (((b) * 2 + (h)) * HTB)
#define PG8_SB(b, h) ((4 + (b) * 2 + (h)) * HTB)
#define PG8_STAGE(bufoff, gbase, voff) do { _Pragma("unroll") for (int _i = 0; _i < 2; ++_i) \
        __builtin_amdgcn_global_load_lds((const unsigned*)((const char*)(gbase) + (voff)[_i]), (PG8_LAS unsigned*)(lds + (bufoff) + ldsw + _i * 8192), 16, 0, 0); } while (0)
#define PG8_LDA(dst, b, h) do { _Pragma("unroll") for (int m = 0; m < 4; ++m) _Pragma("unroll") for (int k = 0; k < 2; ++k) dst[m][k] = *(const PG8_LAS bf16x8*)(lds + PG8_SA(b, h) + aoff + m * 2048 + k * 1024); } while (0)
#define PG8_LDB(dst, b, h) do { _Pragma("unroll") for (int n = 0; n < 2; ++n) _Pragma("unroll") for (int k = 0; k < 2; ++k) dst[n][k] = *(const PG8_LAS bf16x8*)(lds + PG8_SB(b, h) + boff + n * 2048 + k * 1024); } while (0)
#define PG8_MMA(ai, bj, At, Bt) do { __builtin_amdgcn_s_setprio(1); _Pragma("unroll") for (int m = 0; m < 4; ++m) _Pragma("unroll") for (int n = 0; n < 2; ++n) _Pragma("unroll") for (int k = 0; k < 2; ++k) \
        acc[ai][bj][m][n] = __builtin_amdgcn_mfma_f32_16x16x32_bf16(Bt[n][k], At[m][k], acc[ai][bj][m][n], 0, 0, 0); __builtin_amdgcn_s_setprio(0); } while (0)
#define PG8_WAIT_V(n) asm volatile("s_waitcnt vmcnt(" #n ")" ::: "memory")
#define PG8_WAIT_L(n) asm volatile("s_waitcnt lgkmcnt(" #n ")" ::: "memory")
#define PG8_BAR __builtin_amdgcn_s_barrier()
#define PG8_SCHED __builtin_amdgcn_sched_barrier(0)
    Unit cur, nxt; int ui = 0;
    if (!S.next(0, cur)) return;
    f32x4 acc[2][2][4][2];
#pragma unroll
    for (int a = 0; a < 2; ++a)
#pragma unroll
        for (int b = 0; b < 2; ++b)
#pragma unroll
            for (int m = 0; m < 4; ++m)
#pragma unroll
                for (int n = 0; n < 2; ++n) acc[a][b][m][n] = (f32x4){0.f, 0.f, 0.f, 0.f};
    bf16x8 At[4][2], B0[2][2], B1[2][2];
    const char* cA = (const char*)g.A + (size_t)cur.pm * tstep; const char* cB = (const char*)g.Bt + (size_t)cur.pn * tstep;
    S.a_ready(cur);
    PG8_STAGE(PG8_SB(0, 0), cB, voffB); PG8_STAGE(PG8_SB(0, 1), cB + hstep, voffB); PG8_STAGE(PG8_SA(0, 0), cA, voffA); PG8_STAGE(PG8_SA(0, 1), cA + hstep, voffA);
    if (wr == 1) PG8_BAR;
    PG8_WAIT_V(2); PG8_BAR;
    PG8_STAGE(PG8_SB(1, 0), cB + kstep, voffB); PG8_STAGE(PG8_SA(1, 0), cA + kstep, voffA); PG8_STAGE(PG8_SB(1, 1), cB + hstep + kstep, voffB);
    PG8_WAIT_V(6); PG8_BAR;
    for (;;) {
        const bool has_next = S.next(ui + 1, nxt);
        const char* nA = has_next ? (const char*)g.A + (size_t)nxt.pm * tstep : cA; const char* nB = has_next ? (const char*)g.Bt + (size_t)nxt.pn * tstep : cB;
        for (int t = 0; t < nt; t += 2) {
            if constexpr (Epi::MID) { if (t == (nt >> 1)) { E.mid(acc, cur, wr, wc, fr, fq); PG8_SCHED; } }
            const bool last = (t == nt - 2);
            const char* a1 = cA + (size_t)(t + 1) * kstep;
            const char* a2 = last ? nA : cA + (size_t)(t + 2) * kstep; const char* b2 = last ? nB : cB + (size_t)(t + 2) * kstep;
            const char* a3 = a2 + kstep; const char* b3 = b2 + kstep;
            if (last && has_next) S.a_ready(nxt);
            PG8_LDB(B0, 0, 0); PG8_LDB(B1, 0, 1); PG8_SCHED; PG8_LDA(At, 0, 0); PG8_STAGE(PG8_SA(1, 1), a1 + hstep, voffA);
            PG8_WAIT_V(8); PG8_WAIT_L(0); PG8_BAR; PG8_MMA(0, 0, At, B0); PG8_MMA(0, 1, At, B1); PG8_BAR; PG8_SCHED;
            PG8_LDA(At, 0, 1); PG8_STAGE(PG8_SB(0, 0), b2, voffB); PG8_STAGE(PG8_SB(0, 1), b2 + hstep, voffB); PG8_STAGE(PG8_SA(0, 0), a2, voffA);
            PG8_WAIT_V(8); PG8_WAIT_L(0); PG8_BAR; PG8_MMA(1, 0, At, B0); PG8_MMA(1, 1, At, B1); PG8_BAR; PG8_SCHED;
            PG8_LDB(B0, 1, 0); PG8_LDB(B1, 1, 1); PG8_SCHED; PG8_LDA(At, 1, 0); PG8_STAGE(PG8_SA(0, 1), a2 + hstep, voffA);
            PG8_WAIT_V(8); PG8_WAIT_L(0); PG8_BAR; PG8_MMA(0, 0, At, B0); PG8_MMA(0, 1, At, B1); PG8_BAR; PG8_SCHED;
            PG8_LDA(At, 1, 1); PG8_STAGE(PG8_SB(1, 0), b3, voffB); PG8_STAGE(PG8_SB(1, 1), b3 + hstep, voffB); PG8_STAGE(PG8_SA(1, 0), a3, voffA);
            PG8_WAIT_V(8); PG8_WAIT_L(0); PG8_BAR; PG8_MMA(1, 0, At, B0); PG8_MMA(1, 1, At, B1); PG8_BAR; PG8_SCHED;
        }
        if constexpr (ALIGN_EPI) { if (wr == 0) PG8_BAR; }
        E(acc, cur, wr, wc, fr, fq); S.done(cur);
        if (!has_next) break;
#pragma unroll
        for (int a = 0; a < 2; ++a)
#pragma unroll
            for (int b = 0; b < 2; ++b)
#pragma unroll
                for (int m = 0; m < 4; ++m)
#pragma unroll
                    for (int n = 0; n < 2; ++n) acc[a][b][m][n] = (f32x4){0.f, 0.f, 0.f, 0.f};
        cur = nxt; cA = nA; cB = nB; ++ui;
        if constexpr (ALIGN_EPI) { if (wr == 1) PG8_BAR; }
    }
    PG8_WAIT_V(0);
    if constexpr (!ALIGN_EPI) { if (wr == 0) PG8_BAR; }
    PG8_BAR;
#undef PG8_SA
#undef PG8_SB
#undef PG8_STAGE
#undef PG8_LDA
#undef PG8_LDB
#undef PG8_MMA
#undef PG8_WAIT_V
#undef PG8_WAIT_L
#undef PG8_BAR
#undef PG8_SCHED
}
}

constexpr int NWAVES = 8;
constexpr size_t MiB = 1u << 20;
constexpr size_t WS_CTL = 0, CTL_ZERO_BYTES = 64 * 1024;
constexpr size_t WS_CS = 1 * MiB;
constexpr size_t WS_STA = 2 * MiB, WS_STB = 3 * MiB;
constexpr size_t WS_SS = 4 * MiB;
constexpr size_t WS_KM = 5 * MiB;
constexpr size_t WS_W = 8 * MiB, W_BUF = 24 * MiB;
constexpr size_t W_QKV = 0, W_O = 6 * MiB, W_UP = 8 * MiB, W_DN = 16 * MiB;
constexpr size_t WS_XB = 56 * MiB;
constexpr size_t WS_QO = 88 * MiB, WS_KB = 120 * MiB, WS_VB = 152 * MiB;
constexpr size_t WS_H = 88 * MiB;
constexpr size_t WS_END = 216 * MiB;
constexpr int CW_BAR = 1024;

constexpr int RING_BYTES = 131072, LDSCTL_OFF = RING_BYTES, MISC_OFF = LDSCTL_OFF + 320, LDS_BYTES = 147456;

#define GAS __attribute__((address_space(1)))
#define LAS __attribute__((address_space(3)))
typedef unsigned short bf16;
typedef unsigned v4u __attribute__((ext_vector_type(4)));
typedef unsigned v2u __attribute__((ext_vector_type(2)));
typedef float f32x4 __attribute__((ext_vector_type(4)));
typedef GAS unsigned gu32;
#define LDS_WAIT() asm volatile("s_waitcnt lgkmcnt(0)" ::: "memory")
__device__ __forceinline__ unsigned f2bf(float f) { unsigned u = __builtin_bit_cast(unsigned, f); return (u + 0x7fffu + ((u >> 16) & 1u)) >> 16; }
__device__ __forceinline__ unsigned pk2(float lo, float hi) { return f2bf(lo) | (f2bf(hi) << 16); }
__device__ __forceinline__ float bf2f(unsigned h) { return __builtin_bit_cast(float, h << 16); }
__device__ __forceinline__ float wave_sum(float v) {
#pragma unroll
    for (int o = 1; o < 64; o <<= 1) v += __shfl_xor(v, o);
    return v;
}
__device__ __forceinline__ float wave_max(float v) {
#pragma unroll
    for (int o = 1; o < 64; o <<= 1) v = fmaxf(v, __shfl_xor(v, o));
    return v;
}

#define XB_TMO      128
#define XB_XCNT(j)  (256  + 64 * (j))
#define XB_XSUB(j)  (1280 + 64 * (j))
#define XB_XGEN(j)  (2304 + 64 * (j))
#define XB_TOP      3328
#define XB_TOPGEN   3392
#define XCD_BAR_WORDS 3456
#define XB_SPIN_CAP (1u << 18)
__device__ __forceinline__ unsigned xb_ld(unsigned* p)              { return __hip_atomic_load(p, __ATOMIC_RELAXED, __HIP_MEMORY_SCOPE_AGENT); }
__device__ __forceinline__ unsigned xb_add(unsigned* p, unsigned v) { return __hip_atomic_fetch_add(p, v, __ATOMIC_RELAXED, __HIP_MEMORY_SCOPE_AGENT); }
__device__ __forceinline__ unsigned xb_xcc_id() { return (unsigned)__builtin_amdgcn_s_getreg((3 << 11) | 20) & 0xFu; }
#define XB_SPIN(cond, bar) do { unsigned _sp = 0; while (cond) { __builtin_amdgcn_s_sleep(1); \
    if ((++_sp & 255u) == 0u) { if (xb_ld(&(bar)[XB_TMO])) break; if (_sp > XB_SPIN_CAP) { atomicAdd(&(bar)[XB_TMO], 1u); break; } } } } while (0)
struct XcdBarrier { unsigned* bar; unsigned x; volatile LAS unsigned* st; };
__device__ __forceinline__ XcdBarrier xcd_barrier_post(unsigned* bar, volatile LAS unsigned* st) {
    XcdBarrier b; b.bar = bar; b.x = xb_xcc_id(); b.st = st;
    if (threadIdx.x == 0) (void)xb_add(&bar[XB_XCNT(b.x)], 1u);
    return b;
}
__device__ __forceinline__ void xcd_barrier_complete(unsigned* bar, unsigned x, unsigned& nloc, unsigned& nx) {
    const unsigned G = gridDim.x * gridDim.y * gridDim.z;
    unsigned sum, cnt, mine, sp = 0u;
    for (;;) {
        sum = 0u; cnt = 0u; mine = 0u;
#pragma unroll
        for (unsigned j = 0; j < 16; ++j) { const unsigned c = xb_ld(&bar[XB_XCNT(j)]); sum += c; cnt += (c > 0u) ? 1u : 0u; mine = (j == x) ? c : mine; }
        if (sum == G) break;
        __builtin_amdgcn_s_sleep(1);
        if ((++sp & 255u) == 0u) { if (xb_ld(&bar[XB_TMO])) break; if (sp > XB_SPIN_CAP) { atomicAdd(&bar[XB_TMO], 1u); break; } }
    }
    nloc = mine > 0u ? mine : 1u; nx = cnt > 0u ? cnt : 1u;
}
__device__ __forceinline__ void xcd_barrier(const XcdBarrier& b) {
    asm volatile("s_waitcnt vmcnt(0)" ::: "memory");
    __syncthreads();
    if (threadIdx.x == 0) {
        unsigned* bar = b.bar;
        __builtin_amdgcn_s_waitcnt(0);
        unsigned nloc = b.st[0], nx = b.st[1];
        if (nloc == 0u) { xcd_barrier_complete(bar, b.x, nloc, nx); b.st[0] = nloc; b.st[1] = nx; }
        const unsigned old = xb_add(&bar[XB_XSUB(b.x)], 1u);
        const unsigned gen = old / nloc;
        if (old + 1u == (gen + 1u) * nloc) {
            __builtin_amdgcn_fence(__ATOMIC_RELEASE, "agent");
            asm volatile("s_waitcnt vmcnt(0)" ::: "memory");
            const unsigned og = xb_add(&bar[XB_TOP], 1u);
            const unsigned tg = og / nx;
            if (og + 1u == (tg + 1u) * nx) xb_add(&bar[XB_TOPGEN], 1u);
            else XB_SPIN(xb_ld(&bar[XB_TOPGEN]) == tg, bar);
            __builtin_amdgcn_fence(__ATOMIC_ACQUIRE, "agent");
            xb_add(&bar[XB_XGEN(b.x)], 1u);
            asm volatile("s_waitcnt vmcnt(0)" ::: "memory");
        } else {
            XB_SPIN(xb_ld(&bar[XB_XGEN(b.x)]) == gen, bar);
            __builtin_amdgcn_fence(__ATOMIC_ACQUIRE, "agent");
            asm volatile("s_waitcnt vmcnt(0)" ::: "memory");
        }
    }
    __syncthreads();
}

__device__ __forceinline__ void transpose_item(GAS const float* W, int K, int N, GAS const float* gA, GAS const float* gB, int ksplit, GAS bf16* WT, int k0, int nsrc0, int ndst0, LAS float* scr, int lane) {
#pragma unroll 8
    for (int i = 0; i < 32; ++i) { const int kk = 2 * i + (lane >> 5), k = k0 + kk;
        const float g = gA ? (k < ksplit ? gA[k] : gB[k - ksplit]) : 1.0f;
        scr[kk * 33 + (lane & 31)] = W[(size_t)k * N + nsrc0 + (lane & 31)] * g; }
    LDS_WAIT(); asm volatile("" ::: "memory");
    const int c = lane & 7;
#pragma unroll
    for (int j = 0; j < 4; ++j) { const int n = (lane >> 3) + 8 * j; const LAS float* s = scr + (8 * c) * 33 + n;
        v4u o; o.x = pk2(s[0 * 33], s[1 * 33]); o.y = pk2(s[2 * 33], s[3 * 33]); o.z = pk2(s[4 * 33], s[5 * 33]); o.w = pk2(s[6 * 33], s[7 * 33]);
        *(GAS v4u*)(WT + (size_t)(ndst0 + n) * K + k0 + 8 * c) = o; }
    LDS_WAIT(); asm volatile("" ::: "memory");
}
__device__ __forceinline__ int qkv_src_col(int c) {
    const int pn = c >> 8, p = c & 255, tl = 64 * ((p >> 5) & 3) + 32 * (p >> 7), j = 256 * (pn & 3) + tl, a = pn >> 2;
    return (j < 512) ? (a * 512 + j) : (1536 + a * 512 + (j - 512));
}
struct LayerW { GAS const float *attn_norm, *w_in, *moba_norm, *dil_norm, *w_out, *mlp_norm, *w_up, *w_down; };
__device__ __forceinline__ void convert_layer(const LayerW& L, GAS unsigned char* wb, LAS float* scr, int gw, int NGW, int lane) {
    constexpr int I_QKV = (DM / 64) * (NQKV / 32), I_O = (DM / 64) * (DM / 32), I_UP = (DM / 64) * (DFF / 32), I_DN = (DFF / 64) * (DM / 32);
    for (int it = gw; it < I_QKV + I_O + I_UP + I_DN; it += NGW) {
        int r = it; GAS const float* W; GAS const float* gA; GAS const float* gB; int K, N, ksplit, nb, kb, nsrc; GAS bf16* WT;
        if (r < I_QKV) { nb = r % (NQKV / 32); kb = r / (NQKV / 32); W = L.w_in; K = DM; N = NQKV; gA = L.attn_norm; gB = L.attn_norm; ksplit = DM; WT = (GAS bf16*)(wb + W_QKV); nsrc = qkv_src_col(32 * nb); }
        else if (r < I_QKV + I_O) { r -= I_QKV; nb = r % (DM / 32); kb = r / (DM / 32); W = L.w_out; K = DM; N = DM; gA = L.moba_norm; gB = L.dil_norm; ksplit = 512; WT = (GAS bf16*)(wb + W_O); nsrc = 32 * nb; }
        else if (r < I_QKV + I_O + I_UP) { r -= I_QKV + I_O; nb = r % (DFF / 32); kb = r / (DFF / 32); W = L.w_up; K = DM; N = DFF; gA = L.mlp_norm; gB = L.mlp_norm; ksplit = DM; WT = (GAS bf16*)(wb + W_UP); nsrc = 32 * nb; }
        else { r -= I_QKV + I_O + I_UP; nb = r % (DM / 32); kb = r / (DM / 32); W = L.w_down; K = DFF; N = DM; gA = nullptr; gB = nullptr; ksplit = 0; WT = (GAS bf16*)(wb + W_DN); nsrc = 32 * nb; }
        transpose_item(W, K, N, gA, gB, ksplit, WT, 64 * kb, nsrc, 32 * nb, scr, lane);
    }
}

#define KEY_UPDATE(krow, vrow, valid)                                                                                   \
    do {                                                                                                                \
        if (valid) {                                                                                                    \
            float s = 0.f;                                                                                              \
            _Pragma("unroll") for (int c = 0; c < 8; ++c) {                                                             \
                const v4u kk = ((GAS const v4u*)(krow))[c];                                                             \
                s += qv[8 * c + 0] * bf2f(kk.x & 0xffffu) + qv[8 * c + 1] * bf2f(kk.x >> 16) + qv[8 * c + 2] * bf2f(kk.y & 0xffffu) + qv[8 * c + 3] * bf2f(kk.y >> 16) \
                   + qv[8 * c + 4] * bf2f(kk.z & 0xffffu) + qv[8 * c + 5] * bf2f(kk.z >> 16) + qv[8 * c + 6] * bf2f(kk.w & 0xffffu) + qv[8 * c + 7] * bf2f(kk.w >> 16); \
            }                                                                                                           \
            if (s > mrun) { const float f = exp2f(mrun - s); lrun *= f; _Pragma("unroll") for (int d = 0; d < 64; ++d) ov[d] *= f; mrun = s; } \
            const float p = exp2f(s - mrun); lrun += p;                                                                 \
            _Pragma("unroll") for (int c = 0; c < 8; ++c) {                                                             \
                const v4u vv = ((GAS const v4u*)(vrow))[c];                                                             \
                ov[8 * c + 0] += p * bf2f(vv.x & 0xffffu); ov[8 * c + 1] += p * bf2f(vv.x >> 16); ov[8 * c + 2] += p * bf2f(vv.y & 0xffffu); ov[8 * c + 3] += p * bf2f(vv.y >> 16); \
                ov[8 * c + 4] += p * bf2f(vv.z & 0xffffu); ov[8 * c + 5] += p * bf2f(vv.z >> 16); ov[8 * c + 6] += p * bf2f(vv.w & 0xffffu); ov[8 * c + 7] += p * bf2f(vv.w >> 16); \
            }                                                                                                           \
        }                                                                                                               \
    } while (0)
#define WAVE_FINISH(orow, ssptr)                                                                                        \
    do {                                                                                                                \
        const float mall = wave_max(mrun);                                                                              \
        const float f = (mrun > -1e37f) ? exp2f(mrun - mall) : 0.f;                                                     \
        const float ltot = wave_sum(lrun * f); const float il = 1.0f / ltot;                                            \
        float mine = 0.f, sq = 0.f;                                                                                     \
        _Pragma("unroll") for (int d = 0; d < 64; ++d) { const float od = wave_sum(ov[d] * f) * il; sq += od * od; if (lane == d) mine = od; } \
        (orow)[lane] = (bf16)f2bf(mine);                                                                                \
        if (lane == 0) *(ssptr) = sq;                                                                                   \
    } while (0)
#define LOAD_Q(qptr)                                                                                                    \
    float qv[64];                                                                                                       \
    { GAS const v4u* qp = (GAS const v4u*)(qptr);                                                                           \
      _Pragma("unroll") for (int c = 0; c < 8; ++c) { const v4u u = qp[c];                                            \
        qv[8 * c + 0] = bf2f(u.x & 0xffffu); qv[8 * c + 1] = bf2f(u.x >> 16); qv[8 * c + 2] = bf2f(u.y & 0xffffu); qv[8 * c + 3] = bf2f(u.y >> 16); \
        qv[8 * c + 4] = bf2f(u.z & 0xffffu); qv[8 * c + 5] = bf2f(u.z >> 16); qv[8 * c + 6] = bf2f(u.w & 0xffffu); qv[8 * c + 7] = bf2f(u.w >> 16); } }

__device__ __forceinline__ void moba_naive_one(int w, int lane, GAS bf16* QO, GAS const bf16* KB, GAS const bf16* VB, GAS const float* kmean, GAS float* ss) {
    const int t = w & (SEQ - 1), h = (w >> 12) & 7, b = w >> 15, m = b * SEQ + t, qb = t >> 8;
    LOAD_Q(QO + (size_t)m * DM + h * 64);
    float gj;
    { const int j = lane & 15; GAS const f32x4* kmp = (GAS const f32x4*)(kmean + (size_t)((b * 8 + h) * 16 + j) * 64);
      float s = 0.f;
#pragma unroll
      for (int c = 0; c < 16; ++c) { const f32x4 k4 = kmp[c]; s += qv[4 * c] * k4.x + qv[4 * c + 1] * k4.y + qv[4 * c + 2] * k4.z + qv[4 * c + 3] * k4.w; }
      gj = (j < qb) ? s : -1e30f; }
    unsigned sel = 0u;
#pragma unroll
    for (int r = 0; r < 3; ++r) {
        float best = -INFINITY; int bi = 0;
#pragma unroll
        for (int jj = 0; jj < 16; ++jj) { const float v = __shfl(gj, jj); const bool ok = !((sel >> jj) & 1u); if (ok && v > best) { best = v; bi = jj; } }
        sel |= 1u << bi;
    }
    sel &= (1u << qb) - 1u; sel |= 1u << qb;
    float ov[64]; float mrun = -INFINITY, lrun = 0.f;
#pragma unroll
    for (int d = 0; d < 64; ++d) ov[d] = 0.f;
    GAS const bf16* kbase = KB + (size_t)(b * SEQ) * DM + h * 64; GAS const bf16* vbase = VB + (size_t)(b * SEQ) * DM + h * 64;
    for (int jb = 0; jb <= qb; ++jb) {
        if (!((sel >> jb) & 1u)) continue;
        for (int i = 0; i < 4; ++i) { const int key = jb * 256 + i * 64 + lane; const bool valid = key <= t; KEY_UPDATE(kbase + (size_t)key * DM, vbase + (size_t)key * DM, valid); }
    }
    WAVE_FINISH(QO + (size_t)m * DM + h * 64, ss + (size_t)m * 16 + h);
}
__device__ __forceinline__ void dil_naive_one(int w, int lane, GAS bf16* QO, GAS const bf16* KB, GAS const bf16* VB, GAS float* ss) {
    const int t = w & (SEQ - 1), h = (w >> 12) & 7, b = w >> 15, m = b * SEQ + t;
    LOAD_Q(QO + (size_t)m * DM + 512 + h * 64);
    float ov[64]; float mrun = -INFINITY, lrun = 0.f;
#pragma unroll
    for (int d = 0; d < 64; ++d) ov[d] = 0.f;
    GAS const bf16* kbase = KB + (size_t)(b * SEQ) * DM + 512 + h * 64; GAS const bf16* vbase = VB + (size_t)(b * SEQ) * DM + 512 + h * 64;
    for (int cfg = 0; cfg < 3; ++cfg) {
        const int dil = cfg == 0 ? 1 : (cfg == 1 ? 4 : 16);
        for (int i = 0; i < 3; ++i) { const int n = i * 64 + lane; const int key = t - dil * n; const bool valid = (n < 129) && (key >= 0); const int keyc = key < 0 ? 0 : key;
            KEY_UPDATE(kbase + (size_t)keyc * DM, vbase + (size_t)keyc * DM, valid); }
    }
    WAVE_FINISH(QO + (size_t)m * DM + 512 + h * 64, ss + (size_t)m * 16 + 8 + h);
}

struct Args { const float* in[10]; float* out; unsigned char* ws; int ph_lo, ph_hi, li, pad; };
constexpr int PH_PER_LAYER = 6, N_PHASES = 1 + DEPTH * PH_PER_LAYER + 1;
typedef GAS float gf32; typedef GAS const float gcf32; typedef GAS bf16 gbf16; typedef GAS f32x4 gf32x4; typedef GAS const f32x4 gcf32x4;

__global__ void __launch_bounds__(NWAVES * 64, 2) fwd_kernel(Args args) {
    extern __shared__ __attribute__((aligned(16))) unsigned char lds[];
    LAS unsigned char* L = (LAS unsigned char*)lds;
    volatile LAS unsigned* MISC = (volatile LAS unsigned*)(L + MISC_OFF);
    const int G = gridDim.x; const int bx = blockIdx.x;
    const int wave_s = __builtin_amdgcn_readfirstlane(threadIdx.x >> 6);
    gu32* ctl = (gu32*)(args.ws + WS_CTL);
    for (int u = threadIdx.x; u < (LDS_BYTES - LDSCTL_OFF) / 4; u += NWAVES * 64) ((LAS unsigned*)(L + LDSCTL_OFF))[u] = 0u;
    __syncthreads();
    XcdBarrier bar; bar.bar = (unsigned*)(ctl + CW_BAR) + args.li * XCD_BAR_WORDS; bar.x = 0; bar.st = nullptr;
    if (!MK_PER_PHASE) bar = xcd_barrier_post((unsigned*)(ctl + CW_BAR) + args.li * XCD_BAR_WORDS, MISC + 8);
    const int lo = args.ph_lo, hi = args.ph_hi;
#define IN(k) (lo <= (k) && (k) < hi)
#define SEAM(k) do { if (IN(k) && IN((k) + 1)) xcd_barrier(bar); } while (0)
#define OPAQUE_S(p) asm volatile("" : "+s"(p))
#define PHASE_IDS() \
    int lane_; asm volatile("v_mbcnt_lo_u32_b32 %0, -1, 0\n\tv_mbcnt_hi_u32_b32 %0, -1, %0" : "=v"(lane_)); const int lane = lane_, wave = wave_s, tid = wave * 64 + lane; (void)tid; \
    const int vcu = (G % 8 == 0) ? (bx % 8) * (G / 8) + bx / 8 : bx; const int gw = vcu * NWAVES + wave, NGW = G * NWAVES; (void)lane; (void)gw; (void)NGW
#define PHASE_PTRS() \
    unsigned char* ws_ = args.ws; OPAQUE_S(ws_); GAS unsigned char* ws = (GAS unsigned char*)ws_; float* xres_ = args.out; OPAQUE_S(xres_); gf32* xres = (gf32*)xres_; \
    gf32* cs = (gf32*)(ws + WS_CS); gf32* stA = (gf32*)(ws + WS_STA); gf32* stB = (gf32*)(ws + WS_STB); gf32* ss = (gf32*)(ws + WS_SS); gf32* kmean = (gf32*)(ws + WS_KM); \
    gbf16* xb = (gbf16*)(ws + WS_XB); gbf16* QO = (gbf16*)(ws + WS_QO); gbf16* KB = (gbf16*)(ws + WS_KB); gbf16* VB = (gbf16*)(ws + WS_VB); gbf16* HB = (gbf16*)(ws + WS_H); \
    (void)cs; (void)stA; (void)stB; (void)ss; (void)kmean; (void)xb; (void)QO; (void)KB; (void)VB; (void)HB; (void)xres
#define LAYERW(l) LayerW{(gcf32*)args.in[1] + (size_t)(l) * DM, (gcf32*)args.in[2] + (size_t)(l) * DM * NQKV, (gcf32*)args.in[3] + (size_t)(l) * 512, (gcf32*)args.in[4] + (size_t)(l) * 512, \
                         (gcf32*)args.in[5] + (size_t)(l) * DM * DM, (gcf32*)args.in[6] + (size_t)(l) * DM, (gcf32*)args.in[7] + (size_t)(l) * DM * DFF, (gcf32*)args.in[8] + (size_t)(l) * DFF * DM}

    if (IN(0)) {
        PHASE_IDS(); PHASE_PTRS(); gcf32* x_in = (gcf32*)args.in[0];
        LAS float* scr = (LAS float*)(L + wave * 16384);
        for (int idx = bx * (NWAVES * 64) + tid; idx < SEQ * 32; idx += G * NWAVES * 64) {
            const int t = idx >> 5, i = idx & 31;
            const float inv = 1.0f / powf(10000.0f, (float)(2 * i) / 64.0f); const float ang = (float)t * inv;
            cs[idx] = cosf(ang); cs[SEQ * 32 + idx] = sinf(ang);
        }
        { const LayerW LW = LAYERW(0); convert_layer(LW, ws + WS_W, scr, gw, NGW, lane); }
        for (int row = gw; row < M; row += NGW) {
            gcf32x4* xr = (gcf32x4*)(x_in + (size_t)row * DM); float s = 0.f;
#pragma unroll
            for (int j = 0; j < 4; ++j) { const f32x4 v = xr[lane + 64 * j]; s += (v[0] * v[0] + v[1] * v[1]) + (v[2] * v[2] + v[3] * v[3]);
                v2u o; o.x = pk2(v[0], v[1]); o.y = pk2(v[2], v[3]); ((GAS v2u*)(xb + (size_t)row * DM))[lane + 64 * j] = o; }
            s = wave_sum(s);
            if (lane < 16) stA[(size_t)row * 16 + lane] = (lane == 0) ? s : 0.f;
        }
    }
    SEAM(0);

#pragma nounroll
    for (int l = 0; l < DEPTH; ++l) {
        const int p0 = 1 + l * PH_PER_LAYER;
        if (IN(p0)) {
            PHASE_PTRS(); GAS unsigned char* wb = ws + WS_W + (size_t)(l & 1) * W_BUF;
            pg8::Gemm g{(const bf16*)xb, (const bf16*)(wb + W_QKV), M, NQKV, DM}; pg8::StaticOrder S; S.init(M, NQKV, G, bx);
            pg8::EpiQKV E{QO, (size_t)(WS_KB - WS_QO) / 2, stA, cs};
            pg8::gemm_phase<pg8::EpiQKV, pg8::StaticOrder, true>(L, g, S, E, wave_s);
        }
        SEAM(p0);
        if (IN(p0 + 1)) {
            PHASE_IDS(); PHASE_PTRS();
            LAS float* scr = (LAS float*)(L + wave * 16384);
            for (int it = gw; it < BATCH * 8 * 16; it += NGW) {
                const int j = it & 15, h = (it >> 4) & 7, b = it >> 7;
                gbf16* kp = KB + (size_t)(b * SEQ + j * 256) * DM + h * 64 + (lane & 7) * 8;
                float a[8];
#pragma unroll
                for (int d = 0; d < 8; ++d) a[d] = 0.f;
                for (int i = 0; i < 32; ++i) { const v4u u = *(GAS const v4u*)(kp + (size_t)((lane >> 3) + 8 * i) * DM);
                    a[0] += bf2f(u.x & 0xffffu); a[1] += bf2f(u.x >> 16); a[2] += bf2f(u.y & 0xffffu); a[3] += bf2f(u.y >> 16);
                    a[4] += bf2f(u.z & 0xffffu); a[5] += bf2f(u.z >> 16); a[6] += bf2f(u.w & 0xffffu); a[7] += bf2f(u.w >> 16); }
#pragma unroll
                for (int d = 0; d < 8; ++d) { a[d] += __shfl_xor(a[d], 8); a[d] += __shfl_xor(a[d], 16); a[d] += __shfl_xor(a[d], 32); }
                if (lane < 8) { gf32* o = kmean + (size_t)it * 64 + lane * 8;
#pragma unroll
                    for (int d = 0; d < 8; ++d) o[d] = a[d] * (1.0f / 256.0f); }
            }
            if (l + 1 < DEPTH) { const LayerW LW = LAYERW(l + 1); convert_layer(LW, ws + WS_W + (size_t)((l + 1) & 1) * W_BUF, scr, gw, NGW, lane); }
        }
        SEAM(p0 + 1);
        if (IN(p0 + 2)) {
            PHASE_IDS(); PHASE_PTRS();
            for (int w = gw; w < BATCH * 8 * SEQ; w += NGW) { moba_naive_one(w, lane, QO, KB, VB, kmean, ss); dil_naive_one(w, lane, QO, KB, VB, ss); }
        }
        SEAM(p0 + 2);
        if (IN(p0 + 3)) {
            PHASE_PTRS(); GAS unsigned char* wb = ws + WS_W + (size_t)(l & 1) * W_BUF; gcf32* x_in = (gcf32*)args.in[0];
            pg8::Gemm g{(const bf16*)QO, (const bf16*)(wb + W_O), M, DM, DM}; pg8::StaticOrder S; S.init(M, DM, G, bx);
            pg8::EpiRes<true> E{l == 0 ? x_in : (gcf32*)xres, xres, xb, stB, ss};
            pg8::gemm_phase<pg8::EpiRes<true>, pg8::StaticOrder, false>(L, g, S, E, wave_s);
        }
        SEAM(p0 + 3);
        if (IN(p0 + 4)) {
            PHASE_PTRS(); GAS unsigned char* wb = ws + WS_W + (size_t)(l & 1) * W_BUF;
            pg8::Gemm g{(const bf16*)xb, (const bf16*)(wb + W_UP), M, DFF, DM}; pg8::StaticOrder S; S.init(M, DFF, G, bx);
            pg8::EpiUp E{HB, stB};
            pg8::gemm_phase<pg8::EpiUp, pg8::StaticOrder, true>(L, g, S, E, wave_s);
        }
        SEAM(p0 + 4);
        if (IN(p0 + 5)) {
            PHASE_PTRS(); GAS unsigned char* wb = ws + WS_W + (size_t)(l & 1) * W_BUF;
            pg8::Gemm g{(const bf16*)HB, (const bf16*)(wb + W_DN), M, DM, DFF}; pg8::StaticOrder S; S.init(M, DM, G, bx);
            pg8::EpiRes<false> E{(gcf32*)xres, xres, xb, stA, nullptr};
            pg8::gemm_phase<pg8::EpiRes<false>, pg8::StaticOrder, false>(L, g, S, E, wave_s);
        }
        SEAM(p0 + 5);
    }
    if (IN(N_PHASES - 1)) {
        PHASE_IDS(); PHASE_PTRS(); gcf32* gfin = (gcf32*)args.in[9];
        for (int row = gw; row < M; row += NGW) {
            gf32x4* xr = (gf32x4*)(xres + (size_t)row * DM);
            const float r = pg8::row_rs(stA, row, 1.0f / DM);
#pragma unroll
            for (int j = 0; j < 4; ++j) { const f32x4 v = xr[lane + 64 * j]; const f32x4 gg = ((gcf32x4*)gfin)[lane + 64 * j]; xr[lane + 64 * j] = v * r * gg; }
        }
    }
#undef IN
#undef SEAM
}

extern "C" void kernel_launch(void* const* d_in, const int* in_sizes, int n_in, void* d_out, int out_size, void* d_ws, size_t ws_size, hipStream_t stream) {
    static int grid = 0;
    if (grid == 0) {
        if (n_in != 10 || out_size != M * DM || ws_size < WS_END) { fprintf(stderr, "kernel_launch: unexpected shapes (n_in %d out %d ws %zu)\n", n_in, out_size, ws_size); grid = -1; return; }
        int dev = 0, cus = 0, per_cu = 0;
        if (hipGetDevice(&dev) != hipSuccess || hipDeviceGetAttribute(&cus, hipDeviceAttributeMultiprocessorCount, dev) != hipSuccess) { grid = -1; return; }
        if (hipFuncSetAttribute((const void*)fwd_kernel, hipFuncAttributeMaxDynamicSharedMemorySize, LDS_BYTES) != hipSuccess) { fprintf(stderr, "kernel_launch: hipFuncSetAttribute failed\n"); grid = -1; return; }
        if (hipOccupancyMaxActiveBlocksPerMultiprocessor(&per_cu, (const void*)fwd_kernel, NWAVES * 64, LDS_BYTES) != hipSuccess || per_cu < 1)
            fprintf(stderr, "kernel_launch: note: occupancy query reports %d workgroups per CU\n", per_cu);
        (void)hipGetLastError();
        grid = cus;
    }
    if (grid < 0) return;
    if (hipMemsetAsync((char*)d_ws + WS_CTL, 0, CTL_ZERO_BYTES, stream) != hipSuccess) { fprintf(stderr, "kernel_launch: memset failed\n"); return; }
    Args a{};
    for (int i = 0; i < 10; ++i) a.in[i] = (const float*)d_in[i];
    a.out = (float*)d_out; a.ws = (unsigned char*)d_ws;
#if MK_PER_PHASE
    for (int p = 0; p < N_PHASES; ++p) { a.ph_lo = p; a.ph_hi = p + 1; a.li = 0; hipLaunchKernelGGL(fwd_kernel, dim3(grid), dim3(NWAVES * 64), LDS_BYTES, stream, a); }
#else
    a.ph_lo = 0; a.ph_hi = N_PHASES; a.li = 0;
    hipLaunchKernelGGL(fwd_kernel, dim3(grid), dim3(NWAVES * 64), LDS_BYTES, stream, a);
#endif
    const hipError_t le = hipPeekAtLastError();
    if (le != hipSuccess) fprintf(stderr, "kernel_launch: launch failed: %s\n", hipGetErrorName(le));
}
```

```cpp
#include <hip/hip_runtime.h>
#include <cstdio>
#include <cstdint>

#ifndef MK_PER_PHASE
#define MK_PER_PHASE 0
#endif

constexpr int BATCH = 4, SEQ = 4096, DM = 1024, DEPTH = 4, DFF = 4096, M = BATCH * SEQ, NQKV = 3072;
constexpr float NORM_EPS = 1e-6f;
constexpr float C2 = 0.125f * 1.4426950408889634f;

namespace pg8 {
#define PG8_LAS __attribute__((address_space(3)))
typedef unsigned short bf16_t;
typedef short bf16x8 __attribute__((ext_vector_type(8)));
typedef float f32x4 __attribute__((ext_vector_type(4)));
typedef unsigned u32x4 __attribute__((ext_vector_type(4)));
#define PG8_GAS __attribute__((address_space(1)))
typedef PG8_GAS float gf32; typedef PG8_GAS const float gcf32; typedef PG8_GAS bf16_t gbf16;
typedef PG8_GAS f32x4 gf32x4; typedef PG8_GAS const f32x4 gcf32x4; typedef PG8_GAS u32x4 gu32x4;
constexpr int BM = 256, BK = 64, HALF = 128, HTB = HALF * BK * 2, STAGE_BYTES = 8 * HTB, NXCD = 8, WGM = 8;

__host__ __device__ __forceinline__ int lds_byte(int r, int c) { const int st = (r >> 4) * 2 + (c >> 5), rr = r & 15, cc = c & 31, ob = rr * 64 + cc * 2; return st * 1024 + (ob ^ (((ob >> 9) & 1) << 5)); }
__host__ __device__ __forceinline__ void stage_rc(int b, int& R, int& C) { const int st = b / 1024, sb = b % 1024, swz = sb ^ (((sb >> 9) & 1) << 5); R = (st >> 1) * 16 + swz / 64; C = (st & 1) * 32 + (swz % 64) / 2; }
__host__ __device__ __forceinline__ int perm32(int rho) { const int n = rho >> 4, i = rho & 15; return 8 * (i >> 2) + 4 * n + (i & 3); }

struct Unit { int pm, pn; };
struct Gemm { const bf16_t* A; const bf16_t* Bt; int M, N, K; };

struct StaticOrder {
    int nM, nN, nwg, G, c;
    __host__ __device__ void init(int M_, int N_, int G_, int c_) { nM = M_ / BM; nN = N_ / BM; nwg = nM * nN; G = G_; c = c_; }
    __host__ __device__ bool next(int i, Unit& u) const {
        const long L = (long)i * G + c; if (L >= nwg) return false;
        int wgid = (int)L; { const int q = nwg / NXCD, r = nwg % NXCD, xcd = wgid % NXCD, off = wgid / NXCD; wgid = (xcd < r ? xcd * (q + 1) : r * (q + 1) + (xcd - r) * q) + off; }
        const int nig = WGM * nN, gid = wgid / nig, fm = gid * WGM, gsz = (nM - fm) < WGM ? (nM - fm) : WGM;
        u.pm = fm + ((wgid % nig) % gsz); u.pn = (wgid % nig) / gsz; return true;
    }
    __device__ __forceinline__ void a_ready(const Unit&) const {}
    __device__ __forceinline__ void done(const Unit&) const {}
};

__device__ __forceinline__ unsigned cvt_pk_bf16(float lo, float hi) { unsigned r; asm volatile("v_cvt_pk_bf16_f32 %0, %1, %2" : "=v"(r) : "v"(lo), "v"(hi)); return r; }

__device__ __forceinline__ int lane_id_now() { int l; asm volatile("v_mbcnt_lo_u32_b32 %0, -1, 0\n\tv_mbcnt_hi_u32_b32 %0, -1, %0" : "=v"(l)); return l; }
#define PG8_FRESH_LANE() const int lane_f = lane_id_now(), fr = lane_f & 15, fq = lane_f >> 4
__device__ __forceinline__ float row_rs(gcf32* stats, int row, float inv_n) {
    gcf32x4* p = (gcf32x4*)(stats + (size_t)row * 16);
    const f32x4 a = p[0], b = p[1], c = p[2], d = p[3];
    const float s = ((a[0] + a[1]) + (a[2] + a[3])) + ((b[0] + b[1]) + (b[2] + b[3])) + ((c[0] + c[1]) + (c[2] + c[3])) + ((d[0] + d[1]) + (d[2] + d[3]));
    return 1.0f / sqrtf(s * inv_n + NORM_EPS);
}


struct EpiQKV {
    static constexpr bool PERM = true, AFTER_DRAIN = false, MID = false;
    gbf16* Q; size_t arr_stride; gcf32* stats; gcf32* cs; gf32* kpart;
    __device__ __forceinline__ void mid(f32x4 (&)[2][2][4][2], const Unit&, int, int, int, int) const {}
    __device__ __forceinline__ void operator()(const f32x4 (&acc)[2][2][4][2], const Unit& u, int wr, int wc, int, int) const {
        PG8_FRESH_LANE();
        const int arr = u.pn >> 2;
        gbf16* base = Q + (size_t)arr * arr_stride;
        const int col0 = (u.pn & 3) * 256 + 64 * wc + 8 * fq;
        const float qs = arr == 0 ? C2 : 1.0f;
        const bool ksum = (arr == 1) && ((u.pn & 3) < 2);
        f32x4 cs0 = {0.f, 0.f, 0.f, 0.f}, cs1 = cs0, cs2 = cs0, cs3 = cs0;
#pragma unroll
        for (int ai = 0; ai < 2; ++ai)
#pragma unroll
            for (int m = 0; m < 4; ++m) {
                const int row = u.pm * BM + ai * HALF + wr * 64 + m * 16 + fr;
                const float rs = row_rs(stats, row, 1.0f / DM) * qs;
                f32x4 l0 = acc[ai][0][m][0] * rs, l1 = acc[ai][0][m][1] * rs, h0 = acc[ai][1][m][0] * rs, h1 = acc[ai][1][m][1] * rs;
                if (arr < 2) {
                    const int t = row & (SEQ - 1);
                    const f32x4 c0 = *(gcf32x4*)(cs + t * 32 + 8 * fq), c1 = *(gcf32x4*)(cs + t * 32 + 8 * fq + 4);
                    const f32x4 s0 = *(gcf32x4*)(cs + SEQ * 32 + t * 32 + 8 * fq), s1 = *(gcf32x4*)(cs + SEQ * 32 + t * 32 + 8 * fq + 4);
                    const f32x4 o0 = l0 * c0 - h0 * s0, o1 = l1 * c1 - h1 * s1, p0 = h0 * c0 + l0 * s0, p1 = h1 * c1 + l1 * s1;
                    l0 = o0; l1 = o1; h0 = p0; h1 = p1;
                }
                cs0 += l0; cs1 += l1; cs2 += h0; cs3 += h1;
                gbf16* rowp = base + (size_t)row * DM + col0;
                u32x4 w; w.x = cvt_pk_bf16(l0[0], l0[1]); w.y = cvt_pk_bf16(l0[2], l0[3]); w.z = cvt_pk_bf16(l1[0], l1[1]); w.w = cvt_pk_bf16(l1[2], l1[3]);
                *(gu32x4*)rowp = w;
                w.x = cvt_pk_bf16(h0[0], h0[1]); w.y = cvt_pk_bf16(h0[2], h0[3]); w.z = cvt_pk_bf16(h1[0], h1[1]); w.w = cvt_pk_bf16(h1[2], h1[3]);
                *(gu32x4*)(rowp + 32) = w;
                if (m & 1) asm volatile("" ::: "memory");
            }
        if (ksum) {
#pragma unroll
            for (int o = 1; o < 16; o <<= 1)
#pragma unroll
                for (int i = 0; i < 4; ++i) { cs0[i] += __shfl_xor(cs0[i], o); cs1[i] += __shfl_xor(cs1[i], o); cs2[i] += __shfl_xor(cs2[i], o); cs3[i] += __shfl_xor(cs3[i], o); }
            if (fr == 0) {
                const int b = u.pm >> 4, j = u.pm & 15, head = (u.pn & 3) * 4 + wc;
                gf32* kp = kpart + ((size_t)((b * 8 + head) * 16 + j) * 2 + wr) * 64 + 8 * fq;
                *(gf32x4*)kp = cs0; *(gf32x4*)(kp + 4) = cs1; *(gf32x4*)(kp + 32) = cs2; *(gf32x4*)(kp + 36) = cs3;
            }
        }
    }
};

struct EpiUp {
    static constexpr bool PERM = true, AFTER_DRAIN = false, MID = false;
    gbf16* H; gcf32* stats;
    __device__ __forceinline__ void mid(f32x4 (&)[2][2][4][2], const Unit&, int, int, int, int) const {}
    __device__ __forceinline__ void operator()(const f32x4 (&acc)[2][2][4][2], const Unit& u, int wr, int wc, int, int) const {
        PG8_FRESH_LANE();
        const int col0 = u.pn * BM + wc * 32 + 8 * fq;
#pragma unroll
        for (int ai = 0; ai < 2; ++ai)
#pragma unroll
            for (int m = 0; m < 4; ++m) {
                const int row = u.pm * BM + ai * HALF + wr * 64 + m * 16 + fr;
                const float rs = row_rs(stats, row, 1.0f / DM);
                gbf16* rowp = H + (size_t)row * DFF + col0;
#pragma unroll
                for (int bj = 0; bj < 2; ++bj) {
                    f32x4 v0 = acc[ai][bj][m][0] * rs, v1 = acc[ai][bj][m][1] * rs;
#pragma unroll
                    for (int i = 0; i < 4; ++i) { const float a = fmaxf(v0[i], 0.f), b = fmaxf(v1[i], 0.f); v0[i] = a * a; v1[i] = b * b; }
                    u32x4 w; w.x = cvt_pk_bf16(v0[0], v0[1]); w.y = cvt_pk_bf16(v0[2], v0[3]); w.z = cvt_pk_bf16(v1[0], v1[1]); w.w = cvt_pk_bf16(v1[2], v1[3]);
                    *(gu32x4*)(rowp + bj * HALF) = w;
                }
                if (m & 1) asm volatile("" ::: "memory");
            }
    }
};

template <bool TWO_SCALE> struct EpiRes {
    static constexpr bool PERM = true, AFTER_DRAIN = false, MID = TWO_SCALE;
    gcf32* base; gf32* out; gbf16* xb; gf32* stats_out; gcf32* ss;
    __device__ __forceinline__ void half_scales(int row, float& ra, float& rd) const {
        gcf32x4* p = (gcf32x4*)(ss + (size_t)row * 16);
        const f32x4 a = p[0], b = p[1], c = p[2], d = p[3];
        const float sa = ((a[0] + a[1]) + (a[2] + a[3])) + ((b[0] + b[1]) + (b[2] + b[3])), sd = ((c[0] + c[1]) + (c[2] + c[3])) + ((d[0] + d[1]) + (d[2] + d[3]));
        ra = 1.0f / sqrtf(sa * (1.0f / 512.0f) + NORM_EPS); rd = 1.0f / sqrtf(sd * (1.0f / 512.0f) + NORM_EPS);
    }
    __device__ __forceinline__ void mid(f32x4 (&acc)[2][2][4][2], const Unit& u, int wr, int wc, int, int) const {
        if constexpr (TWO_SCALE) {
            PG8_FRESH_LANE(); (void)fq;
#pragma unroll
            for (int ai = 0; ai < 2; ++ai)
#pragma unroll
                for (int m = 0; m < 4; ++m) {
                    const int row = u.pm * BM + ai * HALF + wr * 64 + m * 16 + fr; float ra, rd; half_scales(row, ra, rd); const float f = ra / rd;
#pragma unroll
                    for (int bj = 0; bj < 2; ++bj)
#pragma unroll
                        for (int n = 0; n < 2; ++n) acc[ai][bj][m][n] = acc[ai][bj][m][n] * f;
                    if (m & 1) asm volatile("" ::: "memory");
                }
        }
    }
    __device__ __forceinline__ void operator()(const f32x4 (&acc)[2][2][4][2], const Unit& u, int wr, int wc, int, int) const {
        PG8_FRESH_LANE();
        const int col0 = u.pn * BM + wc * 32 + 8 * fq;
#pragma unroll
        for (int ai = 0; ai < 2; ++ai)
#pragma unroll
            for (int m = 0; m < 4; ++m) {
                const int row = u.pm * BM + ai * HALF + wr * 64 + m * 16 + fr;
                float rd = 1.0f; if constexpr (TWO_SCALE) { float ra; half_scales(row, ra, rd); }
                const size_t off = (size_t)row * DM + col0; float sq = 0.f;
#pragma unroll
                for (int bj = 0; bj < 2; ++bj) {
                    const f32x4 b0 = *(gcf32x4*)(base + off + bj * HALF), b1 = *(gcf32x4*)(base + off + bj * HALF + 4);
                    const f32x4 x0 = b0 + acc[ai][bj][m][0] * rd, x1 = b1 + acc[ai][bj][m][1] * rd;
                    *(gf32x4*)(out + off + bj * HALF) = x0; *(gf32x4*)(out + off + bj * HALF + 4) = x1;
                    sq += ((x0[0] * x0[0] + x0[1] * x0[1]) + (x0[2] * x0[2] + x0[3] * x0[3])) + ((x1[0] * x1[0] + x1[1] * x1[1]) + (x1[2] * x1[2] + x1[3] * x1[3]));
                    u32x4 w; w.x = cvt_pk_bf16(x0[0], x0[1]); w.y = cvt_pk_bf16(x0[2], x0[3]); w.z = cvt_pk_bf16(x1[0], x1[1]); w.w = cvt_pk_bf16(x1[2], x1[3]);
                    *(gu32x4*)(xb + off + bj * HALF) = w;
                }
                sq += __shfl_xor(sq, 16); sq += __shfl_xor(sq, 32);
                if (fq == 0) stats_out[(size_t)row * 16 + u.pn * 4 + wc] = sq;
                asm volatile("" ::: "memory");
            }
    }
};

template <class Epi, class Sched, bool ALIGN_EPI>
__device__ __forceinline__ void gemm_phase(PG8_LAS unsigned char* lds, const Gemm g, const Sched& S, const Epi& E, const int wid_  ) {
    int lane_; asm volatile("v_mbcnt_lo_u32_b32 %0, -1, 0\n\tv_mbcnt_hi_u32_b32 %0, -1, %0" : "=v"(lane_));
    int wid_o = wid_; asm volatile("" : "+s"(wid_o));
    const int lane = lane_, wid = wid_o, tid = wid * 64 + lane, wr = wid >> 2, wc = wid & 3, fr = lane & 15, fq = lane >> 4;
    const int K = g.K, nt = K / BK;
    unsigned voffA[2], voffB[2];
#pragma unroll
    for (int i = 0; i < 2; ++i) { int R, C; stage_rc(tid * 16 + i * 8192, R, C); const int Rb = Epi::PERM ? ((R & ~31) + perm32(R & 31)) : R;
        voffA[i] = (unsigned)(R * K + C) * 2u; voffB[i] = (unsigned)(Rb * K + C) * 2u; }
    const size_t kstep = (size_t)(BK * 2);
    const size_t hstep = (size_t)HALF * K * 2;
    const size_t tstep = 2 * hstep;
    const unsigned ldsw = (unsigned)wid * 1024u;
    const int aoff = lds_byte(wr * 64 + fr, fq * 8), boff = lds_byte(wc * 32 + fr, fq * 8);
#define PG8_SA(b, h) (((b) * 2 + (h)) * HTB)
#define PG8_SB(b, h) ((4 + (b) * 2 + (h)) * HTB)
#define PG8_STAGE(bufoff, gbase, voff) do { _Pragma("unroll") for (int _i = 0; _i < 2; ++_i) \
        __builtin_amdgcn_global_load_lds((const unsigned*)((const char*)(gbase) + (voff)[_i]), (PG8_LAS unsigned*)(lds + (bufoff) + ldsw + _i * 8192), 16, 0, 0); } while (0)
#define PG8_LDA(dst, b, h) do { _Pragma("unroll") for (int m = 0; m < 4; ++m) _Pragma("unroll") for (int k = 0; k < 2; ++k) dst[m][k] = *(const PG8_LAS bf16x8*)(lds + PG8_SA(b, h) + aoff + m * 2048 + k * 1024); } while (0)
#define PG8_LDB(dst, b, h) do { _Pragma("unroll") for (int n = 0; n < 2; ++n) _Pragma("unroll") for (int k = 0; k < 2; ++k) dst[n][k] = *(const PG8_LAS bf16x8*)(lds + PG8_SB(b, h) + boff + n * 2048 + k * 1024); } while (0)
#define PG8_MMA(ai, bj, At, Bt) do { __builtin_amdgcn_s_setprio(1); _Pragma("unroll") for (int m = 0; m < 4; ++m) _Pragma("unroll") for (int n = 0; n < 2; ++n) _Pragma("unroll") for (int k = 0; k < 2; ++k) \
        acc[ai][bj][m][n] = __builtin_amdgcn_mfma_f32_16x16x32_bf16(Bt[n][k], At[m][k], acc[ai][bj][m][n], 0, 0, 0); __builtin_amdgcn_s_setprio(0); } while (0)
#define PG8_WAIT_V(n) asm volatile("s_waitcnt vmcnt(" #n ")" ::: "memory")
#define PG8_WAIT_L(n) asm volatile("s_waitcnt lgkmcnt(" #n ")" ::: "memory")
#define PG8_BAR __builtin_amdgcn_s_barrier()
#define PG8_SCHED __builtin_amdgcn_sched_barrier(0)
    Unit cur, nxt; int ui = 0;
    if (!S.next(0, cur)) return;
    f32x4 acc[2][2][4][2];
#pragma unroll
    for (int a = 0; a < 2; ++a)
#pragma unroll
        for (int b = 0; b < 2; ++b)
#pragma unroll
            for (int m = 0; m < 4; ++m)
#pragma unroll
                for (int n = 0; n < 2; ++n) acc[a][b][m][n] = (f32x4){0.f, 0.f, 0.f, 0.f};
    bf16x8 At[4][2], B0[2][2], B1[2][2];
    const char* cA = (const char*)g.A + (size_t)cur.pm * tstep; const char* cB = (const char*)g.Bt + (size_t)cur.pn * tstep;
    S.a_ready(cur);
    PG8_STAGE(PG8_SB(0, 0), cB, voffB); PG8_STAGE(PG8_SB(0, 1), cB + hstep, voffB); PG8_STAGE(PG8_SA(0, 0), cA, voffA); PG8_STAGE(PG8_SA(0, 1), cA + hstep, voffA);
    if (wr == 1) PG8_BAR;
    PG8_WAIT_V(2); PG8_BAR;
    PG8_STAGE(PG8_SB(1, 0), cB + kstep, voffB); PG8_STAGE(PG8_SA(1, 0), cA + kstep, voffA); PG8_STAGE(PG8_SB(1, 1), cB + hstep + kstep, voffB);
    PG8_WAIT_V(6); PG8_BAR;
    for (;;) {
        const bool has_next = S.next(ui + 1, nxt);
        const char* nA = has_next ? (const char*)g.A + (size_t)nxt.pm * tstep : cA; const char* nB = has_next ? (const char*)g.Bt + (size_t)nxt.pn * tstep : cB;
        for (int t = 0; t < nt; t += 2) {
            if constexpr (Epi::MID) { if (t == (nt >> 1)) { E.mid(acc, cur, wr, wc, fr, fq); PG8_SCHED; } }
            const bool last = (t == nt - 2);
            const char* a1 = cA + (size_t)(t + 1) * kstep;
            const char* a2 = last ? nA : cA + (size_t)(t + 2) * kstep; const char* b2 = last ? nB : cB + (size_t)(t + 2) * kstep;
            const char* a3 = a2 + kstep; const char* b3 = b2 + kstep;
            if (last && has_next) S.a_ready(nxt);
            PG8_LDB(B0, 0, 0); PG8_LDB(B1, 0, 1); PG8_SCHED; PG8_LDA(At, 0, 0); PG8_STAGE(PG8_SA(1, 1), a1 + hstep, voffA);
            PG8_WAIT_V(8); PG8_WAIT_L(0); PG8_BAR; PG8_MMA(0, 0, At, B0); PG8_MMA(0, 1, At, B1); PG8_BAR; PG8_SCHED;
            PG8_LDA(At, 0, 1); PG8_STAGE(PG8_SB(0, 0), b2, voffB); PG8_STAGE(PG8_SB(0, 1), b2 + hstep, voffB); PG8_STAGE(PG8_SA(0, 0), a2, voffA);
            PG8_WAIT_V(8); PG8_WAIT_L(0); PG8_BAR; PG8_MMA(1, 0, At, B0); PG8_MMA(1, 1, At, B1); PG8_BAR; PG8_SCHED;
            PG8_LDB(B0, 1, 0); PG8_LDB(B1, 1, 1); PG8_SCHED; PG8_LDA(At, 1, 0); PG8_STAGE(PG8_SA(0, 1), a2 + hstep, voffA);
            PG8_WAIT_V(8); PG8_WAIT_L(0); PG8_BAR; PG8_MMA(0, 0, At, B0); PG8_MMA(0, 1, At, B1); PG8_BAR; PG8_SCHED;
            PG8_LDA(At, 1, 1); PG8_STAGE(PG8_SB(1, 0), b3, voffB); PG8_STAGE(PG8_SB(1, 1), b3 + hstep, voffB); PG8_STAGE(PG8_SA(1, 0), a3, voffA);
            PG8_WAIT_V(8); PG8_WAIT_L(0); PG8_BAR; PG8_MMA(1, 0, At, B0); PG8_MMA(1, 1, At, B1); PG8_BAR; PG8_SCHED;
        }
        if constexpr (ALIGN_EPI) { if (wr == 0) PG8_BAR; }
        E(acc, cur, wr, wc, fr, fq); S.done(cur);
        if (!has_next) break;
#pragma unroll
        for (int a = 0; a < 2; ++a)
#pragma unroll
            for (int b = 0; b < 2; ++b)
#pragma unroll
                for (int m = 0; m < 4; ++m)
#pragma unroll
                    for (int n = 0; n < 2; ++n) acc[a][b][m][n] = (f32x4){0.f, 0.f, 0.f, 0.f};
        cur = nxt; cA = nA; cB = nB; ++ui;
        if constexpr (ALIGN_EPI) { if (wr == 1) PG8_BAR; }
    }
    PG8_WAIT_V(0);
    if constexpr (!ALIGN_EPI) { if (wr == 0) PG8_BAR; }
    PG8_BAR;
#undef PG8_SA
#undef PG8_SB
#undef PG8_STAGE
#undef PG8_LDA
#undef PG8_LDB
#undef PG8_MMA
#undef PG8_WAIT_V
#undef PG8_WAIT_L
#undef PG8_BAR
#undef PG8_SCHED
}
}

namespace attn_body {
using bf16x8=__attribute__((ext_vector_type(8)))short;
using s16x4=__attribute__((ext_vector_type(4)))short;
using f32x16=__attribute__((ext_vector_type(16)))float;
using u32x4=__attribute__((ext_vector_type(4)))unsigned;
using f32x4=__attribute__((ext_vector_type(4)))float;
typedef unsigned short bf16;
#define AGAS __attribute__((address_space(1)))
constexpr int D=64,DMP=1024;
constexpr int NW=8,QBLK=32,QB=QBLK*NW,KVBLK=64;
__device__ __forceinline__ int crow(int r,int hi){return (r&3)+8*(r>>2)+4*hi;}
#define SBAR() __builtin_amdgcn_sched_barrier(0)
__device__ __forceinline__ void cmask(f32x16&p0,f32x16&p1,int jb,int qrel,int hi){
  const float NEG=-INFINITY; int kb=64*jb+4*hi;
  #pragma unroll
  for(int r=0;r<16;++r){int kv=kb+(r&3)+8*(r>>2); if(kv>qrel)p0[r]=NEG; if(kv+32>qrel)p1[r]=NEG;}
}
constexpr int NSLOT=3, SLOTB=8192;
constexpr int LDS_K=0, LDS_V=NSLOT*SLOTB, LDS_WS=2*NSLOT*SLOTB, LDS_OST=LDS_WS+NW*64*4, LDS_BYTES=LDS_OST+NW*4096;
__device__ __forceinline__ void glds16(const void*gsrc,unsigned lds_dst){unsigned keep;
  asm volatile("s_mov_b32 %0, m0\n\ts_mov_b32 m0, %2\n\ts_nop 0\n\tglobal_load_lds_dwordx4 %1, off\n\ts_mov_b32 m0, %0":"=&s"(keep):"v"(gsrc),"s"(lds_dst):"memory");}
__device__ __forceinline__ float max3f(float a,float b,float c){float r;asm("v_max3_f32 %0, %1, %2, %3":"=v"(r):"v"(a),"v"(b),"v"(c));return r;}
__device__ __forceinline__ float max2f(float a,float b){float r;asm("v_max_f32_e32 %0, %1, %2":"=v"(r):"v"(a),"v"(b));return r;}
__device__ __forceinline__ float fadd_s(float a,float b){float r;asm("v_add_f32_e32 %0, %1, %2":"=v"(r):"v"(a),"v"(b));return r;}
__device__ __forceinline__ float fsub_s(float a,float b){float r;asm("v_sub_f32_e32 %0, %1, %2":"=v"(r):"v"(a),"v"(b));return r;}
typedef float f32x2_t __attribute__((ext_vector_type(2))); typedef __bf16 bf16x2_t __attribute__((ext_vector_type(2)));
__device__ __forceinline__ unsigned cvtpk_s(float lo,float hi){f32x2_t v={lo,hi};bf16x2_t b=__builtin_convertvector(v,bf16x2_t);return __builtin_bit_cast(unsigned,b);}
#define WAIT_BAR(N) asm volatile("s_waitcnt vmcnt(" #N ") lgkmcnt(0)\n\ts_barrier":::"memory")
__device__ __forceinline__ void qkt(f32x16&p0,f32x16&p1,const char*Kslot,const bf16x8*qr,const f32x16&negm,int r32,int hi){
  const char*kb=Kslot+hi*1024+r32*16;
  #pragma unroll
  for(int d0=0;d0<4;++d0){
    const bf16x8 b0=*reinterpret_cast<const bf16x8*>(kb+d0*2048);
    const bf16x8 b1=*reinterpret_cast<const bf16x8*>(kb+d0*2048+512);
    if(d0==0){p0=__builtin_amdgcn_mfma_f32_32x32x16_bf16(b0,qr[0],negm,0,0,0);p1=__builtin_amdgcn_mfma_f32_32x32x16_bf16(b1,qr[0],negm,0,0,0);}
    else{p0=__builtin_amdgcn_mfma_f32_32x32x16_bf16(b0,qr[d0],p0,0,0,0);p1=__builtin_amdgcn_mfma_f32_32x32x16_bf16(b1,qr[d0],p1,0,0,0);}}
}
typedef __attribute__((address_space(3))) const char* lds_cptr;
typedef short v4i16_t __attribute__((ext_vector_type(4)));
__device__ __forceinline__ void kload8(bf16x8*kf,lds_cptr kp){
  kf[0]=*(const __attribute__((address_space(3))) bf16x8*)(kp);      kf[1]=*(const __attribute__((address_space(3))) bf16x8*)(kp+512);
  kf[2]=*(const __attribute__((address_space(3))) bf16x8*)(kp+2048); kf[3]=*(const __attribute__((address_space(3))) bf16x8*)(kp+2560);
  kf[4]=*(const __attribute__((address_space(3))) bf16x8*)(kp+4096); kf[5]=*(const __attribute__((address_space(3))) bf16x8*)(kp+4608);
  kf[6]=*(const __attribute__((address_space(3))) bf16x8*)(kp+6144); kf[7]=*(const __attribute__((address_space(3))) bf16x8*)(kp+6656);
}
__device__ __forceinline__ void kload2(bf16x8*kf,lds_cptr kp,int j){ kf[2*j]=*(const __attribute__((address_space(3))) bf16x8*)(kp+j*2048); kf[2*j+1]=*(const __attribute__((address_space(3))) bf16x8*)(kp+j*2048+512); }
__device__ __forceinline__ s16x4 vtr(lds_cptr p){ return __builtin_bit_cast(s16x4,__builtin_amdgcn_ds_read_tr16_b64_v4i16((__attribute__((address_space(3))) v4i16_t*)p)); }
__device__ __forceinline__ float rowmax(const f32x16&p0,const f32x16&p1){
  float a=max3f(p0[0],p0[1],p1[0]),b=max3f(p0[2],p0[3],p1[1]);a=max3f(a,p1[2],p1[3]);
  #pragma unroll
  for(int r=4;r<16;r+=4){a=max3f(a,p0[r],p0[r+1]);b=max3f(b,p0[r+2],p0[r+3]);a=max3f(a,p1[r],p1[r+1]);b=max3f(b,p1[r+2],p1[r+3]);}
  const float m=max2f(a,b);
  auto rr=__builtin_amdgcn_permlane32_swap(__float_as_uint(m),__float_as_uint(m),false,false);
  return max2f(__uint_as_float(rr[0]),__uint_as_float(rr[1]));
}
__device__ __forceinline__ void pv(f32x16*o,int vb,bf16x8 pa0,bf16x8 pa1,bf16x8 pa2,bf16x8 pa3){
  #pragma unroll
  for(int d0=0;d0<2;++d0){s16x4 lo[4],hi[4];
    #pragma unroll
    for(int ks=0;ks<4;++ks){
      asm volatile("ds_read_b64_tr_b16 %0,%1 offset:%c2":"=&v"(lo[ks]):"v"(vb),"i"(d0*4096+ks*1024):"memory");
      asm volatile("ds_read_b64_tr_b16 %0,%1 offset:%c2":"=&v"(hi[ks]):"v"(vb),"i"(d0*4096+ks*1024+512):"memory");}
    asm volatile("s_waitcnt lgkmcnt(0)":::"memory");SBAR();
    #define PK(k) (bf16x8){lo[k][0],lo[k][1],lo[k][2],lo[k][3],hi[k][0],hi[k][1],hi[k][2],hi[k][3]}
    o[d0]=__builtin_amdgcn_mfma_f32_32x32x16_bf16(pa0,PK(0),o[d0],0,0,0);
    o[d0]=__builtin_amdgcn_mfma_f32_32x32x16_bf16(pa1,PK(1),o[d0],0,0,0);
    o[d0]=__builtin_amdgcn_mfma_f32_32x32x16_bf16(pa2,PK(2),o[d0],0,0,0);
    o[d0]=__builtin_amdgcn_mfma_f32_32x32x16_bf16(pa3,PK(3),o[d0],0,0,0);
    #undef PK
  }
}
__device__ __forceinline__ unsigned short f2bf_s(float f){ unsigned u=__builtin_bit_cast(unsigned,f); return (unsigned short)((u+0x7fffu+((u>>16)&1u))>>16); }

template<int THRL> __device__ __forceinline__ void moba_unit(int b,int h,int qb,int SEQL,AGAS const bf16*Q,AGAS const bf16*K,AGAS const bf16*V,AGAS bf16*O,AGAS const float*kpart,AGAS float*ss,char*shm,const int wid){
  int lane_; asm volatile("v_mbcnt_lo_u32_b32 %0, -1, 0\n\tv_mbcnt_hi_u32_b32 %0, -1, %0":"=v"(lane_));
  const int lane=lane_,r32=lane&31,hi=lane>>5;
  const long rowbase=(long)b*SEQL; const int q0=qb*QB;
  AGAS const bf16*Qw=Q+(rowbase+q0+wid*QBLK)*DMP+h*D;
  AGAS const bf16*Kh=K+rowbase*DMP+h*D; AGAS const bf16*Vh=V+rowbase*DMP+h*D;
  const unsigned lds0=(unsigned)(uintptr_t)shm;
  float*wsf=(float*)(shm+LDS_WS)+wid*64;
  AGAS const bf16*ksrc=Kh+(long)lane*DMP+wid*8;
  AGAS const bf16*vsrc=Vh+(long)(16*(wid&3)+(lane>>2))*DMP+(wid>>2)*32+(lane&3)*8;
  const unsigned kdst=lds0+LDS_K+wid*1024, vdst=lds0+LDS_V+wid*1024;
  #define DMA_K(t,slot) glds16((const void*)(ksrc+(long)(t)*KVBLK*DMP),(unsigned)__builtin_amdgcn_readfirstlane(kdst+(slot)))
  #define DMA_V(t,slot) glds16((const void*)(vsrc+(long)(t)*KVBLK*DMP),(unsigned)__builtin_amdgcn_readfirstlane(vdst+(slot)))
  const int vb0=(int)(lds0+LDS_V)+((lane>>4)&1)*32+(lane&3)*8+(4*hi+((lane&15)>>2))*64;
  const char*Kbase=shm+LDS_K; bf16x8 kf[8];
  const lds_cptr shm3=(lds_cptr)shm; const lds_cptr kp0=shm3+LDS_K+hi*1024+r32*16; const lds_cptr vp0=shm3+LDS_V+((lane>>4)&1)*32+(lane&3)*8+(4*hi+((lane&15)>>2))*64;
  const int NT=(q0+QB)/KVBLK;
  DMA_K(0,0);DMA_V(0,0);DMA_K(1,SLOTB);
  bf16x8 qr[4];
  #pragma unroll
  for(int d0=0;d0<4;++d0)qr[d0]=*reinterpret_cast<AGAS const bf16x8*>(&Qw[(long)r32*DMP+d0*16+hi*8]);
  unsigned selbits=1u<<qb;
  if(qb>0){
    f32x16 g=f32x16{};
    { AGAS const float*kp=kpart+((size_t)((b*8+h)*16+(r32&15))*2)*64+8*hi;
      #pragma unroll
      for(int d0=0;d0<4;++d0){
        f32x4 a0=*(AGAS const f32x4*)(kp+16*d0),a1=*(AGAS const f32x4*)(kp+16*d0+4),c0=*(AGAS const f32x4*)(kp+64+16*d0),c1=*(AGAS const f32x4*)(kp+64+16*d0+4);
        a0=(a0+c0)*(1.0f/256.0f); a1=(a1+c1)*(1.0f/256.0f);
        if(r32>=16){a0=f32x4{0.f,0.f,0.f,0.f};a1=a0;}
        bf16x8 kh,kl;
        #pragma unroll
        for(int i=0;i<4;++i){ const unsigned short h0=f2bf_s(a0[i]),h1=f2bf_s(a1[i]); kh[i]=(short)h0; kh[4+i]=(short)h1;
          kl[i]=(short)f2bf_s(a0[i]-__builtin_bit_cast(float,(unsigned)h0<<16)); kl[4+i]=(short)f2bf_s(a1[i]-__builtin_bit_cast(float,(unsigned)h1<<16)); }
        g=__builtin_amdgcn_mfma_f32_32x32x16_bf16(kh,qr[d0],g,0,0,0);
        g=__builtin_amdgcn_mfma_f32_32x32x16_bf16(kl,qr[d0],g,0,0,0);
      } }
    float gv[16];
    #pragma unroll
    for(int r=0;r<8;++r){ auto rr=__builtin_amdgcn_permlane32_swap(__float_as_uint(g[r]),__float_as_uint(g[r]),false,false);
      const int j0=(r&3)+8*(r>>2); gv[j0]=(j0<qb)?__uint_as_float(rr[0]):-1e30f; gv[j0+4]=(j0+4<qb)?__uint_as_float(rr[1]):-1e30f; }
    unsigned sel=0u;
    #pragma unroll
    for(int rep=0;rep<3;++rep){ float best=-INFINITY; int bi=0;
      #pragma unroll
      for(int j=0;j<16;++j){ const bool ok=!((sel>>j)&1u); if(ok&&gv[j]>best){best=gv[j];bi=j;} }
      sel|=1u<<bi; }
    selbits=(sel&((1u<<qb)-1u))|(1u<<qb);
  }
  #define MASKOF(tt) ((unsigned)(-(int)((selbits>>((tt)>>2))&1u)))
  #define SELOF(tt) (((selbits>>((tt)>>2))&1u)!=0u)
  float mhat=0.f,l_reg=0.f;f32x16 o[2];o[0]=f32x16{};o[1]=f32x16{};f32x16 negm=f32x16{};asm volatile("":"+v"(negm));
  const int qrel=wid*QBLK+r32;
  #define CMASK(P0,P1,t) do{int jb_=(t)-(NT-4); if(jb_>=0)cmask(P0,P1,jb_,qrel,hi);}while(0)
  bool resc=false;
  #define START(P0,P1) do{ const float rm=rowmax(P0,P1); resc=false; \
    { const float dl=rm; mhat=fadd_s(mhat,dl); \
      _Pragma("unroll") for(int r=0;r<16;++r){P0[r]=fsub_s(P0[r],dl);P1[r]=fsub_s(P1[r],dl);} \
      _Pragma("unroll") for(int r=0;r<16;++r)negm[r]=-mhat; asm volatile("":"+v"(negm)); } \
    _Pragma("unroll") for(int r=0;r<16;++r)P0[r]=__builtin_amdgcn_exp2f(P0[r]); }while(0)
  #define RESC() do{ if(resc){ asm volatile("s_waitcnt lgkmcnt(0)":::"memory"); \
      _Pragma("unroll") for(int d_=0;d_<2;++d_) _Pragma("unroll") for(int r=0;r<16;++r)o[d_][r]*=wsf[crow(r,hi)]; } }while(0)
  f32x16 pA0,pA1,pB0,pB1;
  int sl_prev=0,sl_cur=0,sl_next=SLOTB;
  #define ROT() do{sl_prev=sl_cur;sl_cur=sl_next;sl_next=(sl_next==(NSLOT-1)*SLOTB)?0:sl_next+SLOTB;}while(0)
  DMA_K(2,2*SLOTB);
  WAIT_BAR(3);
  qkt(pA0,pA1,Kbase,qr,negm,r32,hi);asm volatile("s_nop 15\n\ts_nop 7":"+v"(pA0),"+v"(pA1));CMASK(pA0,pA1,0);
  START(pA0,pA1);
  _Pragma("unroll") for(int r=0;r<16;++r)pA1[r]=__builtin_amdgcn_exp2f(pA1[r]);
  WAIT_BAR(0);
  DMA_K(3,0);DMA_V(1,SLOTB);
  ROT();
  kload8(kf,kp0+sl_cur);
  WAIT_BAR(2);
  s16x4 vlo[8],vhi[8]; u32x4 pw0,pw1,pw2,pw3;
  #define PKW(P,B) cvtpk_s(P[B],P[B+1])
  #define PAF(k) __builtin_bit_cast(bf16x8,pw##k)
  #define VFR(i) (bf16x8){vlo[i][0],vlo[i][1],vlo[i][2],vlo[i][3],vhi[i][0],vhi[i][1],vhi[i][2],vhi[i][3]}
  #define PIN(x) asm volatile("":"+v"(x))
  #define MX3(a,b,c) __builtin_fmaxf(__builtin_fmaxf((a),(b)),(c))
  #define GAPA(MF,A0,A1,A2,A3,W0,W1,PW) do{ MF; sacc+=A0; sacc+=A1; sacc+=A2; sacc+=A3; PIN(sacc); W0; W1; PIN(PW); SBAR(); }while(0)
  #define EX(v) __builtin_amdgcn_exp2f(v)
  #define GAPB(MF,X,B) do{ MF; X[B]=EX(X[B]); X[B+1]=EX(X[B+1]); X[B+2]=EX(X[B+2]); X[B+3]=EX(X[B+3]); PIN(X); SBAR(); }while(0)
  #define VRD(i) do{ vlo[i]=vtr(vp_+(((i)>>2)*4096+((i)&3)*1024)); vhi[i]=vtr(vp_+(((i)>>2)*4096+((i)&3)*1024+512)); }while(0)
  #define KRD(G,j) do{ if(G){ kload2(kf,kp0+sl_next,j); SBAR(); } }while(0)
  #define STEP(C0,C1,P0,P1,t,GK,GV,GL,MP,SC) do{ SBAR(); \
    const lds_cptr vp_=vp0+sl_prev; \
    VRD(0); SBAR(); float sacc=(P0[0]+P0[1]); \
    GAPA(C0=__builtin_amdgcn_mfma_f32_32x32x16_bf16(kf[0],qr[0],negm,0,0,0), P0[2],P0[3],P0[4],P0[5],     pw0[0]=PKW(P0,0), pw0[1]=PKW(P0,2), pw0); \
    VRD(4); SBAR(); GAPA(C1=__builtin_amdgcn_mfma_f32_32x32x16_bf16(kf[1],qr[0],negm,0,0,0), P0[6],P0[7],P0[8],P0[9],     pw0[2]=PKW(P0,4), pw0[3]=PKW(P0,6), pw0); \
    VRD(1); SBAR(); GAPA(C0=__builtin_amdgcn_mfma_f32_32x32x16_bf16(kf[2],qr[1],C0,0,0,0),   P0[10],P0[11],P0[12],P0[13], pw1[0]=PKW(P0,8), pw1[1]=PKW(P0,10), pw1); \
    VRD(5); SBAR(); GAPA(C1=__builtin_amdgcn_mfma_f32_32x32x16_bf16(kf[3],qr[1],C1,0,0,0),   P0[14],P0[15],P1[0],P1[1],   pw1[2]=PKW(P0,12),pw1[3]=PKW(P0,14), pw1); \
    VRD(2); SBAR(); GAPA(C0=__builtin_amdgcn_mfma_f32_32x32x16_bf16(kf[4],qr[2],C0,0,0,0),   P1[2],P1[3],P1[4],P1[5],     pw2[0]=PKW(P1,0), pw2[1]=PKW(P1,2), pw2); \
    VRD(6); SBAR(); GAPA(C1=__builtin_amdgcn_mfma_f32_32x32x16_bf16(kf[5],qr[2],C1,0,0,0),   P1[6],P1[7],P1[8],P1[9],     pw2[2]=PKW(P1,4), pw2[3]=PKW(P1,6), pw2); \
    VRD(3); SBAR(); GAPA(C0=__builtin_amdgcn_mfma_f32_32x32x16_bf16(kf[6],qr[3],C0,0,0,0),   P1[10],P1[11],P1[12],P1[13], pw3[0]=PKW(P1,8), pw3[1]=PKW(P1,10), pw3); \
    VRD(7); SBAR(); GAPA(C1=__builtin_amdgcn_mfma_f32_32x32x16_bf16(kf[7],qr[3],C1,0,0,0),   P1[14],P1[15],0.f,0.f,       pw3[2]=PKW(P1,12),pw3[3]=PKW(P1,14), pw3); \
    { const unsigned mp_=(MP); l_reg+=__uint_as_float(__float_as_uint(sacc)&mp_); pw0&=mp_; pw1&=mp_; pw2&=mp_; pw3&=mp_; } \
    if(GK){DMA_K((t)+3,sl_cur);} if(GV){DMA_V((t)+1,sl_next);} \
    CMASK(C0,C1,t); \
    { float a=MX3(C0[0],C0[1],C1[0]),b=MX3(C0[2],C0[3],C1[1]); a=MX3(a,C1[2],C1[3]); \
      _Pragma("unroll") for(int r=4;r<16;r+=4){a=MX3(a,C0[r],C0[r+1]);b=MX3(b,C0[r+2],C0[r+3]);a=MX3(a,C1[r],C1[r+1]);b=MX3(b,C1[r+2],C1[r+3]);} \
      float rm=__builtin_fmaxf(a,b); { auto rr=__builtin_amdgcn_permlane32_swap(__float_as_uint(rm),__float_as_uint(rm),false,false); rm=__builtin_fmaxf(__uint_as_float(rr[0]),__uint_as_float(rr[1])); } \
      rm=(SC)?rm:-INFINITY; \
      resc=false; \
      if(__builtin_expect(__any(rm>(float)THRL),0)){ const float dl=__builtin_fmaxf(rm,0.f); mhat+=dl; \
        _Pragma("unroll") for(int r=0;r<16;++r){C0[r]-=dl;C1[r]-=dl;} \
        _Pragma("unroll") for(int r=0;r<16;++r)negm[r]=-mhat; asm volatile("":"+v"(negm)); \
        const float f=__builtin_amdgcn_exp2f(-dl); l_reg*=f; if(hi==0)wsf[r32]=f; resc=true; } } \
    SBAR(); \
    GAPB(o[0]=__builtin_amdgcn_mfma_f32_32x32x16_bf16(PAF(0),VFR(0),o[0],0,0,0), C0,0); \
    GAPB(o[1]=__builtin_amdgcn_mfma_f32_32x32x16_bf16(PAF(0),VFR(4),o[1],0,0,0), C0,4); \
    KRD(GL,0); GAPB(o[0]=__builtin_amdgcn_mfma_f32_32x32x16_bf16(PAF(1),VFR(1),o[0],0,0,0), C0,8); \
    KRD(GL,1); GAPB(o[1]=__builtin_amdgcn_mfma_f32_32x32x16_bf16(PAF(1),VFR(5),o[1],0,0,0), C0,12); \
    KRD(GL,2); GAPB(o[0]=__builtin_amdgcn_mfma_f32_32x32x16_bf16(PAF(2),VFR(2),o[0],0,0,0), C1,0); \
    KRD(GL,3); GAPB(o[1]=__builtin_amdgcn_mfma_f32_32x32x16_bf16(PAF(2),VFR(6),o[1],0,0,0), C1,4); \
    GAPB(o[0]=__builtin_amdgcn_mfma_f32_32x32x16_bf16(PAF(3),VFR(3),o[0],0,0,0), C1,8); \
    GAPB(o[1]=__builtin_amdgcn_mfma_f32_32x32x16_bf16(PAF(3),VFR(7),o[1],0,0,0), C1,12); \
    }while(0)
  int t=1;
  #undef CMASK
  #define CMASK(P0,P1,t) do{}while(0)
  for(;t+5<NT;t+=2){
    STEP(pB0,pB1,pA0,pA1,t,true,true,true,MASKOF(t-1),SELOF(t));     WAIT_BAR(2); RESC(); ROT();
    STEP(pA0,pA1,pB0,pB1,t+1,true,true,true,MASKOF(t),SELOF(t+1));   WAIT_BAR(2); RESC(); ROT();
  }
  #undef CMASK
  #define CMASK(P0,P1,t) do{int jb_=(t)-(NT-4); if(jb_>=0)cmask(P0,P1,jb_,qrel,hi);}while(0)
  #define ENDW(tt) do{ if((tt)+3<NT){WAIT_BAR(2);} else if((tt)+2<NT){WAIT_BAR(1);} else {WAIT_BAR(0);} }while(0)
  for(;t+1<NT;t+=2){
    STEP(pB0,pB1,pA0,pA1,t,(t+3<NT),(t+1<NT),(t+1<NT),MASKOF(t-1),SELOF(t));       ENDW(t);   RESC(); ROT();
    STEP(pA0,pA1,pB0,pB1,t+1,(t+4<NT),(t+2<NT),(t+2<NT),MASKOF(t),SELOF(t+1));     ENDW(t+1); RESC(); ROT();
  }
  STEP(pB0,pB1,pA0,pA1,NT-1,false,false,false,MASKOF(NT-2),true); RESC();
  { float sacc=pB0[0]+pB0[1]; _Pragma("unroll") for(int r=2;r<16;++r)sacc+=pB0[r]; _Pragma("unroll") for(int r=0;r<16;++r)sacc+=pB1[r]; l_reg+=sacc;
    pw0=(u32x4){PKW(pB0,0),PKW(pB0,2),PKW(pB0,4),PKW(pB0,6)};pw1=(u32x4){PKW(pB0,8),PKW(pB0,10),PKW(pB0,12),PKW(pB0,14)};pw2=(u32x4){PKW(pB1,0),PKW(pB1,2),PKW(pB1,4),PKW(pB1,6)};pw3=(u32x4){PKW(pB1,8),PKW(pB1,10),PKW(pB1,12),PKW(pB1,14)};
    SBAR(); pv(o,vb0+sl_cur,PAF(0),PAF(1),PAF(2),PAF(3)); }
  #undef PKW
  #undef PAF
  #undef VFR
  #undef PIN
  #undef MX3
  #undef GAPA
  #undef GAPB
  #undef EX
  #undef VRD
  #undef KRD
  #undef STEP
  #undef ENDW
  {auto rr=__builtin_amdgcn_permlane32_swap(__float_as_uint(l_reg),__float_as_uint(l_reg),false,false);l_reg=__uint_as_float(rr[0])+__uint_as_float(rr[1]);}
  if(hi==0)wsf[32+r32]=l_reg;asm volatile("s_waitcnt lgkmcnt(0)":::"memory");
  float rli[16];
  #pragma unroll
  for(int r=0;r<16;++r)rli[r]=__builtin_amdgcn_rcpf(wsf[32+crow(r,hi)]);
  AGAS bf16*Ow=O+(rowbase+q0+wid*QBLK)*DMP+h*D;
  { bf16*stg=(bf16*)(shm+LDS_OST)+wid*2048;
    #pragma unroll
    for(int r=0;r<16;++r){const int orow=crow(r,hi);
      #pragma unroll
      for(int d0=0;d0<2;++d0)stg[orow*64+d0*32+r32]=f2bf_s(o[d0][r]*rli[r]);}
    asm volatile("s_waitcnt lgkmcnt(0)":::"memory");
    #pragma unroll
    for(int i=0;i<4;++i){const int row=i*8+(lane>>3),ch=lane&7; const u32x4 v=*(const u32x4*)(stg+row*64+ch*8); *(AGAS u32x4*)(Ow+(long)row*DMP+ch*8)=v;
      float sq=0.f;
      #pragma unroll
      for(int e=0;e<4;++e){ const float lo=__builtin_bit_cast(float,v[e]<<16), hi2=__builtin_bit_cast(float,v[e]&0xffff0000u); sq+=lo*lo+hi2*hi2; }
      sq+=__shfl_xor(sq,1); sq+=__shfl_xor(sq,2); sq+=__shfl_xor(sq,4);
      if(ch==0) ss[(size_t)(rowbase+q0+wid*QBLK+row)*16+h]=sq; } }
  asm volatile("s_waitcnt lgkmcnt(0)\n\ts_barrier":::"memory");
  #undef DMA_K
  #undef DMA_V
  #undef CMASK
  #undef START
  #undef RESC
  #undef ROT
  #undef MASKOF
  #undef SELOF
}
constexpr int ATTN_LDS_BYTES=LDS_BYTES;
#undef SBAR
#undef WAIT_BAR
}

namespace dil_body {
using attn_body::bf16x8; using attn_body::s16x4; using attn_body::f32x16; using attn_body::u32x4; using attn_body::bf16; using attn_body::lds_cptr;
using attn_body::crow; using attn_body::glds16; using attn_body::vtr; using attn_body::cvtpk_s; using attn_body::f2bf_s;
constexpr int NGRP=33, WBUF=8192, WLDS=2*WBUF;
#define DGAS __attribute__((address_space(1)))
#define DLAS __attribute__((address_space(3)))
template<int THRL> __device__ __forceinline__ void dil_item(int b,int h,int blk,int r,int SEQL,DGAS const bf16*Q,DGAS const bf16*K,DGAS const bf16*V,DGAS bf16*O,DGAS float*ss,char*wlds,float*wsf){
  int lane_; asm volatile("v_mbcnt_lo_u32_b32 %0, -1, 0\n\tv_mbcnt_hi_u32_b32 %0, -1, %0":"=v"(lane_));
  const int lane=lane_,r32=lane&31,hi=lane>>5;
  const int T0=blk*512, tq=T0+r+16*r32; const long rowbase=(long)b*SEQL;
  DGAS const bf16*Qrow=Q+(rowbase+tq)*1024+512+h*64;
  DGAS const bf16*Kh=K+rowbase*1024+512+h*64; DGAS const bf16*Vh=V+rowbase*1024+512+h*64;
  bf16x8 qr[4];
  #pragma unroll
  for(int d0=0;d0<4;++d0)qr[d0]=*reinterpret_cast<DGAS const bf16x8*>(Qrow+d0*16+hi*8);
  asm volatile("s_waitcnt vmcnt(0)":"+v"(qr[0]),"+v"(qr[1]),"+v"(qr[2]),"+v"(qr[3])::"memory");
  const unsigned lds0=(unsigned)(uintptr_t)wlds; const lds_cptr w3=(lds_cptr)wlds;
  #define GPARAMS(gi,base,sh,W) int base,sh,W; if((gi)<5){sh=4;base=T0+r-2048+512*(gi);W=2048;} else if((gi)<13){sh=2;base=T0+(r&3)-512+128*((gi)-5);W=512;} else {sh=0;base=T0+r-128+32*((gi)-13);W=128;}
  #define CLAMPT(x) ((x)<0?0:((x)>SEQL-1?SEQL-1:(x)))
  #define ISSUE(gi,buf) do{ GPARAMS(gi,base_,sh_,W_); (void)W_; \
      const int tk_=CLAMPT(base_+((lane&31)<<sh_)); DGAS const bf16*ks_=Kh+(long)tk_*1024+(lane>>5)*8; \
      const int tv0_=CLAMPT(base_+((lane>>2)<<sh_)), tv1_=CLAMPT(base_+(((lane>>2)+16)<<sh_)); \
      DGAS const bf16*vs0_=Vh+(long)tv0_*1024+(lane&3)*8; DGAS const bf16*vs1_=Vh+(long)tv1_*1024+(lane&3)*8; \
      const unsigned kd_=(unsigned)__builtin_amdgcn_readfirstlane(lds0+(buf)*WBUF), vd_=kd_+4096; \
      glds16((const void*)(ks_),kd_); glds16((const void*)(ks_+16),kd_+1024); glds16((const void*)(ks_+32),kd_+2048); glds16((const void*)(ks_+48),kd_+3072); \
      glds16((const void*)(vs0_),vd_); glds16((const void*)(vs1_),vd_+1024); glds16((const void*)(vs0_+32),vd_+2048); glds16((const void*)(vs1_+32),vd_+3072); }while(0)
  float mhat=0.f,l_reg=0.f; f32x16 o[2]; o[0]=f32x16{}; o[1]=f32x16{}; f32x16 negm=f32x16{};
  ISSUE(0,0);
  #pragma nounroll
  for(int gi=0;gi<NGRP;++gi){
    const int buf=gi&1;
    if(gi+1<NGRP){ ISSUE(gi+1,buf^1); asm volatile("s_waitcnt vmcnt(8)":::"memory"); } else { asm volatile("s_waitcnt vmcnt(0)":::"memory"); }
    const lds_cptr kp=w3+buf*WBUF+hi*512+r32*16;
    f32x16 p;
    { const bf16x8 k0=*(DLAS const bf16x8*)(kp), k1=*(DLAS const bf16x8*)(kp+1024), k2=*(DLAS const bf16x8*)(kp+2048), k3=*(DLAS const bf16x8*)(kp+3072);
      p=__builtin_amdgcn_mfma_f32_32x32x16_bf16(k0,qr[0],negm,0,0,0); p=__builtin_amdgcn_mfma_f32_32x32x16_bf16(k1,qr[1],p,0,0,0);
      p=__builtin_amdgcn_mfma_f32_32x32x16_bf16(k2,qr[2],p,0,0,0); p=__builtin_amdgcn_mfma_f32_32x32x16_bf16(k3,qr[3],p,0,0,0); }
    { GPARAMS(gi,base,sh,W); const unsigned bound=(unsigned)(W<tq?W:tq); const int dl0=tq-base-((4*hi)<<sh);
      #pragma unroll
      for(int rr=0;rr<16;++rr){ const int dlt=dl0-(((rr&3)+8*(rr>>2))<<sh); if((unsigned)dlt>bound)p[rr]=-INFINITY; } }
    float rm=p[0];
    #pragma unroll
    for(int rr=1;rr<16;++rr)rm=__builtin_fmaxf(rm,p[rr]);
    { auto sw=__builtin_amdgcn_permlane32_swap(__float_as_uint(rm),__float_as_uint(rm),false,false); rm=__builtin_fmaxf(__uint_as_float(sw[0]),__uint_as_float(sw[1])); }
    bool resc=false;
    if(gi==0){ const float dl=(rm>-INFINITY)?rm:0.f; mhat=dl;
      #pragma unroll
      for(int rr=0;rr<16;++rr){p[rr]-=dl; negm[rr]=-mhat;} }
    else if(__any(rm>(float)THRL)){ const float dl=__builtin_fmaxf(rm,0.f); mhat+=dl;
      #pragma unroll
      for(int rr=0;rr<16;++rr){p[rr]-=dl; negm[rr]=-mhat;}
      const float f=__builtin_amdgcn_exp2f(-dl); l_reg*=f; if(hi==0)wsf[r32]=f; resc=true; }
    float sacc=0.f;
    #pragma unroll
    for(int rr=0;rr<16;++rr){p[rr]=__builtin_amdgcn_exp2f(p[rr]); sacc+=p[rr];}
    l_reg+=sacc;
    if(resc){ asm volatile("s_waitcnt lgkmcnt(0)":::"memory");
      #pragma unroll
      for(int d_=0;d_<2;++d_)
        #pragma unroll
        for(int rr=0;rr<16;++rr)o[d_][rr]*=wsf[crow(rr,hi)]; }
    u32x4 pw0,pw1;
    pw0=(u32x4){cvtpk_s(p[0],p[1]),cvtpk_s(p[2],p[3]),cvtpk_s(p[4],p[5]),cvtpk_s(p[6],p[7])};
    pw1=(u32x4){cvtpk_s(p[8],p[9]),cvtpk_s(p[10],p[11]),cvtpk_s(p[12],p[13]),cvtpk_s(p[14],p[15])};
    const lds_cptr vp=w3+buf*WBUF+4096+((lane>>4)&1)*32+(lane&3)*8+(4*hi+((lane&15)>>2))*64;
    #pragma unroll
    for(int d0=0;d0<2;++d0){
      const s16x4 a0=vtr(vp+d0*2048), a1=vtr(vp+d0*2048+512), c0=vtr(vp+d0*2048+1024), c1=vtr(vp+d0*2048+1536);
      const bf16x8 v0=(bf16x8){a0[0],a0[1],a0[2],a0[3],a1[0],a1[1],a1[2],a1[3]}, v1=(bf16x8){c0[0],c0[1],c0[2],c0[3],c1[0],c1[1],c1[2],c1[3]};
      o[d0]=__builtin_amdgcn_mfma_f32_32x32x16_bf16(__builtin_bit_cast(bf16x8,pw0),v0,o[d0],0,0,0);
      o[d0]=__builtin_amdgcn_mfma_f32_32x32x16_bf16(__builtin_bit_cast(bf16x8,pw1),v1,o[d0],0,0,0); }
    asm volatile("s_waitcnt lgkmcnt(0)":::"memory");
  }
  {auto sw=__builtin_amdgcn_permlane32_swap(__float_as_uint(l_reg),__float_as_uint(l_reg),false,false);l_reg=__uint_as_float(sw[0])+__uint_as_float(sw[1]);}
  if(hi==0)wsf[32+r32]=l_reg; asm volatile("s_waitcnt lgkmcnt(0)":::"memory");
  float rli[16];
  #pragma unroll
  for(int rr=0;rr<16;++rr)rli[rr]=__builtin_amdgcn_rcpf(wsf[32+crow(rr,hi)]);
  { bf16*stg=(bf16*)wlds;
    #pragma unroll
    for(int rr=0;rr<16;++rr){const int orow=crow(rr,hi);
      #pragma unroll
      for(int d0=0;d0<2;++d0)stg[orow*64+d0*32+r32]=f2bf_s(o[d0][rr]*rli[rr]);}
    asm volatile("s_waitcnt lgkmcnt(0)":::"memory");
    #pragma unroll
    for(int i=0;i<4;++i){const int row=i*8+(lane>>3),ch=lane&7; const u32x4 v=*(const u32x4*)(stg+row*64+ch*8);
      const long grow=rowbase+T0+r+16*row;
      *(DGAS u32x4*)(O+grow*1024+512+h*64+ch*8)=v;
      float sq=0.f;
      #pragma unroll
      for(int e=0;e<4;++e){ const float lo=__builtin_bit_cast(float,v[e]<<16), hi2=__builtin_bit_cast(float,v[e]&0xffff0000u); sq+=lo*lo+hi2*hi2; }
      sq+=__shfl_xor(sq,1); sq+=__shfl_xor(sq,2); sq+=__shfl_xor(sq,4);
      if(ch==0) ss[(size_t)grow*16+8+h]=sq; }
    asm volatile("s_waitcnt lgkmcnt(0)":::"memory"); }
  #undef GPARAMS
  #undef CLAMPT
  #undef ISSUE
}
}

constexpr int NWAVES = 8;
constexpr size_t MiB = 1u << 20;
constexpr size_t WS_CTL = 0, CTL_ZERO_BYTES = 64 * 1024;
constexpr size_t WS_CS = 1 * MiB;
constexpr size_t WS_STA = 2 * MiB, WS_STB = 3 * MiB;
constexpr size_t WS_SS = 4 * MiB;
constexpr size_t WS_KM = 5 * MiB;
constexpr size_t WS_W = 8 * MiB, W_BUF = 24 * MiB;
constexpr size_t W_QKV = 0, W_O = 6 * MiB, W_UP = 8 * MiB, W_DN = 16 * MiB;
constexpr size_t WS_XB = 56 * MiB;
constexpr size_t WS_QO = 88 * MiB, WS_KB = 120 * MiB, WS_VB = 152 * MiB;
constexpr size_t WS_H = 88 * MiB;
constexpr size_t WS_END = 216 * MiB;
constexpr int CW_BAR = 1024;

constexpr int RING_BYTES = 131072, LDSCTL_OFF = RING_BYTES, MISC_OFF = LDSCTL_OFF + 320, LDS_BYTES = 147456;

#define GAS __attribute__((address_space(1)))
#define LAS __attribute__((address_space(3)))
typedef unsigned short bf16;
typedef unsigned v4u __attribute__((ext_vector_type(4)));
typedef unsigned v2u __attribute__((ext_vector_type(2)));
typedef float f32x4 __attribute__((ext_vector_type(4)));
typedef GAS unsigned gu32;
#define LDS_WAIT() asm volatile("s_waitcnt lgkmcnt(0)" ::: "memory")
__device__ __forceinline__ unsigned f2bf(float f) { unsigned u = __builtin_bit_cast(unsigned, f); return (u + 0x7fffu + ((u >> 16) & 1u)) >> 16; }
__device__ __forceinline__ unsigned pk2(float lo, float hi) { return f2bf(lo) | (f2bf(hi) << 16); }
__device__ __forceinline__ float bf2f(unsigned h) { return __builtin_bit_cast(float, h << 16); }
__device__ __forceinline__ float wave_sum(float v) {
#pragma unroll
    for (int o = 1; o < 64; o <<= 1) v += __shfl_xor(v, o);
    return v;
}
__device__ __forceinline__ float wave_max(float v) {
#pragma unroll
    for (int o = 1; o < 64; o <<= 1) v = fmaxf(v, __shfl_xor(v, o));
    return v;
}

#define XB_TMO      128
#define XB_XCNT(j)  (256  + 64 * (j))
#define XB_XSUB(j)  (1280 + 64 * (j))
#define XB_XGEN(j)  (2304 + 64 * (j))
#define XB_TOP      3328
#define XB_TOPGEN   3392
#define XCD_BAR_WORDS 3456
#define XB_SPIN_CAP (1u << 18)
__device__ __forceinline__ unsigned xb_ld(unsigned* p)              { return __hip_atomic_load(p, __ATOMIC_RELAXED, __HIP_MEMORY_SCOPE_AGENT); }
__device__ __forceinline__ unsigned xb_add(unsigned* p, unsigned v) { return __hip_atomic_fetch_add(p, v, __ATOMIC_RELAXED, __HIP_MEMORY_SCOPE_AGENT); }
__device__ __forceinline__ unsigned xb_xcc_id() { return (unsigned)__builtin_amdgcn_s_getreg((3 << 11) | 20) & 0xFu; }
#define XB_SPIN(cond, bar) do { unsigned _sp = 0; while (cond) { __builtin_amdgcn_s_sleep(1); \
    if ((++_sp & 255u) == 0u) { if (xb_ld(&(bar)[XB_TMO])) break; if (_sp > XB_SPIN_CAP) { atomicAdd(&(bar)[XB_TMO], 1u); break; } } } } while (0)
struct XcdBarrier { unsigned* bar; unsigned x; volatile LAS unsigned* st; };
__device__ __forceinline__ XcdBarrier xcd_barrier_post(unsigned* bar, volatile LAS unsigned* st) {
    XcdBarrier b; b.bar = bar; b.x = xb_xcc_id(); b.st = st;
    if (threadIdx.x == 0) (void)xb_add(&bar[XB_XCNT(b.x)], 1u);
    return b;
}
__device__ __forceinline__ void xcd_barrier_complete(unsigned* bar, unsigned x, unsigned& nloc, unsigned& nx) {
    const unsigned G = gridDim.x * gridDim.y * gridDim.z;
    unsigned sum, cnt, mine, sp = 0u;
    for (;;) {
        sum = 0u; cnt = 0u; mine = 0u;
#pragma unroll
        for (unsigned j = 0; j < 16; ++j) { const unsigned c = xb_ld(&bar[XB_XCNT(j)]); sum += c; cnt += (c > 0u) ? 1u : 0u; mine = (j == x) ? c : mine; }
        if (sum == G) break;
        __builtin_amdgcn_s_sleep(1);
        if ((++sp & 255u) == 0u) { if (xb_ld(&bar[XB_TMO])) break; if (sp > XB_SPIN_CAP) { atomicAdd(&bar[XB_TMO], 1u); break; } }
    }
    nloc = mine > 0u ? mine : 1u; nx = cnt > 0u ? cnt : 1u;
}
__device__ __forceinline__ void xcd_barrier(const XcdBarrier& b) {
    asm volatile("s_waitcnt vmcnt(0)" ::: "memory");
    __syncthreads();
    if (threadIdx.x == 0) {
        unsigned* bar = b.bar;
        __builtin_amdgcn_s_waitcnt(0);
        unsigned nloc = b.st[0], nx = b.st[1];
        if (nloc == 0u) { xcd_barrier_complete(bar, b.x, nloc, nx); b.st[0] = nloc; b.st[1] = nx; }
        const unsigned old = xb_add(&bar[XB_XSUB(b.x)], 1u);
        const unsigned gen = old / nloc;
        if (old + 1u == (gen + 1u) * nloc) {
            __builtin_amdgcn_fence(__ATOMIC_RELEASE, "agent");
            asm volatile("s_waitcnt vmcnt(0)" ::: "memory");
            const unsigned og = xb_add(&bar[XB_TOP], 1u);
            const unsigned tg = og / nx;
            if (og + 1u == (tg + 1u) * nx) xb_add(&bar[XB_TOPGEN], 1u);
            else XB_SPIN(xb_ld(&bar[XB_TOPGEN]) == tg, bar);
            __builtin_amdgcn_fence(__ATOMIC_ACQUIRE, "agent");
            xb_add(&bar[XB_XGEN(b.x)], 1u);
            asm volatile("s_waitcnt vmcnt(0)" ::: "memory");
        } else {
            XB_SPIN(xb_ld(&bar[XB_XGEN(b.x)]) == gen, bar);
            __builtin_amdgcn_fence(__ATOMIC_ACQUIRE, "agent");
            asm volatile("s_waitcnt vmcnt(0)" ::: "memory");
        }
    }
    __syncthreads();
}

__device__ __forceinline__ void transpose_item(GAS const float* W, int K, int N, GAS const float* gA, GAS const float* gB, int ksplit, GAS bf16* WT, int k0, int nsrc0, int ndst0, LAS float* scr, int lane) {
#pragma unroll 8
    for (int i = 0; i < 32; ++i) { const int kk = 2 * i + (lane >> 5), k = k0 + kk;
        const float g = gA ? (k < ksplit ? gA[k] : gB[k - ksplit]) : 1.0f;
        scr[kk * 33 + (lane & 31)] = W[(size_t)k * N + nsrc0 + (lane & 31)] * g; }
    LDS_WAIT(); asm volatile("" ::: "memory");
    const int c = lane & 7;
#pragma unroll
    for (int j = 0; j < 4; ++j) { const int n = (lane >> 3) + 8 * j; const LAS float* s = scr + (8 * c) * 33 + n;
        v4u o; o.x = pk2(s[0 * 33], s[1 * 33]); o.y = pk2(s[2 * 33], s[3 * 33]); o.z = pk2(s[4 * 33], s[5 * 33]); o.w = pk2(s[6 * 33], s[7 * 33]);
        *(GAS v4u*)(WT + (size_t)(ndst0 + n) * K + k0 + 8 * c) = o; }
    LDS_WAIT(); asm volatile("" ::: "memory");
}
__device__ __forceinline__ int qkv_src_col(int c) {
    const int pn = c >> 8, p = c & 255, tl = 64 * ((p >> 5) & 3) + 32 * (p >> 7), j = 256 * (pn & 3) + tl, a = pn >> 2;
    return (j < 512) ? (a * 512 + j) : (1536 + a * 512 + (j - 512));
}
struct LayerW { GAS const float *attn_norm, *w_in, *moba_norm, *dil_norm, *w_out, *mlp_norm, *w_up, *w_down; };
__device__ __forceinline__ void convert_layer(const LayerW& L, GAS unsigned char* wb, LAS float* scr, int gw, int NGW, int lane) {
    constexpr int I_QKV = (DM / 64) * (NQKV / 32), I_O = (DM / 64) * (DM / 32), I_UP = (DM / 64) * (DFF / 32), I_DN = (DFF / 64) * (DM / 32);
    for (int it = gw; it < I_QKV + I_O + I_UP + I_DN; it += NGW) {
        int r = it; GAS const float* W; GAS const float* gA; GAS const float* gB; int K, N, ksplit, nb, kb, nsrc; GAS bf16* WT;
        if (r < I_QKV) { nb = r % (NQKV / 32); kb = r / (NQKV / 32); W = L.w_in; K = DM; N = NQKV; gA = L.attn_norm; gB = L.attn_norm; ksplit = DM; WT = (GAS bf16*)(wb + W_QKV); nsrc = qkv_src_col(32 * nb); }
        else if (r < I_QKV + I_O) { r -= I_QKV; nb = r % (DM / 32); kb = r / (DM / 32); W = L.w_out; K = DM; N = DM; gA = L.moba_norm; gB = L.dil_norm; ksplit = 512; WT = (GAS bf16*)(wb + W_O); nsrc = 32 * nb; }
        else if (r < I_QKV + I_O + I_UP) { r -= I_QKV + I_O; nb = r % (DFF / 32); kb = r / (DFF / 32); W = L.w_up; K = DM; N = DFF; gA = L.mlp_norm; gB = L.mlp_norm; ksplit = DM; WT = (GAS bf16*)(wb + W_UP); nsrc = 32 * nb; }
        else { r -= I_QKV + I_O + I_UP; nb = r % (DM / 32); kb = r / (DM / 32); W = L.w_down; K = DFF; N = DM; gA = nullptr; gB = nullptr; ksplit = 0; WT = (GAS bf16*)(wb + W_DN); nsrc = 32 * nb; }
        transpose_item(W, K, N, gA, gB, ksplit, WT, 64 * kb, nsrc, 32 * nb, scr, lane);
    }
}

#define KEY_UPDATE(krow, vrow, valid)                                                                                   \
    do {                                                                                                                \
        if (valid) {                                                                                                    \
            float s = 0.f;                                                                                              \
            _Pragma("unroll") for (int c = 0; c < 8; ++c) {                                                             \
                const v4u kk = ((GAS const v4u*)(krow))[c];                                                             \
                s += qv[8 * c + 0] * bf2f(kk.x & 0xffffu) + qv[8 * c + 1] * bf2f(kk.x >> 16) + qv[8 * c + 2] * bf2f(kk.y & 0xffffu) + qv[8 * c + 3] * bf2f(kk.y >> 16) \
                   + qv[8 * c + 4] * bf2f(kk.z & 0xffffu) + qv[8 * c + 5] * bf2f(kk.z >> 16) + qv[8 * c + 6] * bf2f(kk.w & 0xffffu) + qv[8 * c + 7] * bf2f(kk.w >> 16); \
            }                                                                                                           \
            if (s > mrun) { const float f = exp2f(mrun - s); lrun *= f; _Pragma("unroll") for (int d = 0; d < 64; ++d) ov[d] *= f; mrun = s; } \
            const float p = exp2f(s - mrun); lrun += p;                                                                 \
            _Pragma("unroll") for (int c = 0; c < 8; ++c) {                                                             \
                const v4u vv = ((GAS const v4u*)(vrow))[c];                                                             \
                ov[8 * c + 0] += p * bf2f(vv.x & 0xffffu); ov[8 * c + 1] += p * bf2f(vv.x >> 16); ov[8 * c + 2] += p * bf2f(vv.y & 0xffffu); ov[8 * c + 3] += p * bf2f(vv.y >> 16); \
                ov[8 * c + 4] += p * bf2f(vv.z & 0xffffu); ov[8 * c + 5] += p * bf2f(vv.z >> 16); ov[8 * c + 6] += p * bf2f(vv.w & 0xffffu); ov[8 * c + 7] += p * bf2f(vv.w >> 16); \
            }                                                                                                           \
        }                                                                                                               \
    } while (0)
#define WAVE_FINISH(orow, ssptr)                                                                                        \
    do {                                                                                                                \
        const float mall = wave_max(mrun);                                                                              \
        const float f = (mrun > -1e37f) ? exp2f(mrun - mall) : 0.f;                                                     \
        const float ltot = wave_sum(lrun * f); const float il = 1.0f / ltot;                                            \
        float mine = 0.f, sq = 0.f;                                                                                     \
        _Pragma("unroll") for (int d = 0; d < 64; ++d) { const float od = wave_sum(ov[d] * f) * il; sq += od * od; if (lane == d) mine = od; } \
        (orow)[lane] = (bf16)f2bf(mine);                                                                                \
        if (lane == 0) *(ssptr) = sq;                                                                                   \
    } while (0)
#define LOAD_Q(qptr)                                                                                                    \
    float qv[64];                                                                                                       \
    { GAS const v4u* qp = (GAS const v4u*)(qptr);                                                                           \
      _Pragma("unroll") for (int c = 0; c < 8; ++c) { const v4u u = qp[c];                                            \
        qv[8 * c + 0] = bf2f(u.x & 0xffffu); qv[8 * c + 1] = bf2f(u.x >> 16); qv[8 * c + 2] = bf2f(u.y & 0xffffu); qv[8 * c + 3] = bf2f(u.y >> 16); \
        qv[8 * c + 4] = bf2f(u.z & 0xffffu); qv[8 * c + 5] = bf2f(u.z >> 16); qv[8 * c + 6] = bf2f(u.w & 0xffffu); qv[8 * c + 7] = bf2f(u.w >> 16); } }

__device__ __forceinline__ void moba_naive_one(int w, int lane, GAS bf16* QO, GAS const bf16* KB, GAS const bf16* VB, GAS const float* kmean, GAS float* ss) {
    const int t = w & (SEQ - 1), h = (w >> 12) & 7, b = w >> 15, m = b * SEQ + t, qb = t >> 8;
    LOAD_Q(QO + (size_t)m * DM + h * 64);
    float gj;
    { const int j = lane & 15; GAS const f32x4* kmp = (GAS const f32x4*)(kmean + (size_t)((b * 8 + h) * 16 + j) * 64);
      float s = 0.f;
#pragma unroll
      for (int c = 0; c < 16; ++c) { const f32x4 k4 = kmp[c]; s += qv[4 * c] * k4.x + qv[4 * c + 1] * k4.y + qv[4 * c + 2] * k4.z + qv[4 * c + 3] * k4.w; }
      gj = (j < qb) ? s : -1e30f; }
    unsigned sel = 0u;
#pragma unroll
    for (int r = 0; r < 3; ++r) {
        float best = -INFINITY; int bi = 0;
#pragma unroll
        for (int jj = 0; jj < 16; ++jj) { const float v = __shfl(gj, jj); const bool ok = !((sel >> jj) & 1u); if (ok && v > best) { best = v; bi = jj; } }
        sel |= 1u << bi;
    }
    sel &= (1u << qb) - 1u; sel |= 1u << qb;
    float ov[64]; float mrun = -INFINITY, lrun = 0.f;
#pragma unroll
    for (int d = 0; d < 64; ++d) ov[d] = 0.f;
    GAS const bf16* kbase = KB + (size_t)(b * SEQ) * DM + h * 64; GAS const bf16* vbase = VB + (size_t)(b * SEQ) * DM + h * 64;
    for (int jb = 0; jb <= qb; ++jb) {
        if (!((sel >> jb) & 1u)) continue;
        for (int i = 0; i < 4; ++i) { const int key = jb * 256 + i * 64 + lane; const bool valid = key <= t; KEY_UPDATE(kbase + (size_t)key * DM, vbase + (size_t)key * DM, valid); }
    }
    WAVE_FINISH(QO + (size_t)m * DM + h * 64, ss + (size_t)m * 16 + h);
}
__device__ __forceinline__ void dil_naive_one(int w, int lane, GAS bf16* QO, GAS const bf16* KB, GAS const bf16* VB, GAS float* ss) {
    const int t = w & (SEQ - 1), h = (w >> 12) & 7, b = w >> 15, m = b * SEQ + t;
    LOAD_Q(QO + (size_t)m * DM + 512 + h * 64);
    float ov[64]; float mrun = -INFINITY, lrun = 0.f;
#pragma unroll
    for (int d = 0; d < 64; ++d) ov[d] = 0.f;
    GAS const bf16* kbase = KB + (size_t)(b * SEQ) * DM + 512 + h * 64; GAS const bf16* vbase = VB + (size_t)(b * SEQ) * DM + 512 + h * 64;
    for (int cfg = 0; cfg < 3; ++cfg) {
        const int dil = cfg == 0 ? 1 : (cfg == 1 ? 4 : 16);
        for (int i = 0; i < 3; ++i) { const int n = i * 64 + lane; const int key = t - dil * n; const bool valid = (n < 129) && (key >= 0); const int keyc = key < 0 ? 0 : key;
            KEY_UPDATE(kbase + (size_t)keyc * DM, vbase + (size_t)keyc * DM, valid); }
    }
    WAVE_FINISH(QO + (size_t)m * DM + 512 + h * 64, ss + (size_t)m * 16 + 8 + h);
}

struct Args { const float* in[10]; float* out; unsigned char* ws; int ph_lo, ph_hi, li, pad; };
constexpr int PH_PER_LAYER = 6, N_PHASES = 1 + DEPTH * PH_PER_LAYER + 1;
typedef GAS float gf32; typedef GAS const float gcf32; typedef GAS bf16 gbf16; typedef GAS f32x4 gf32x4; typedef GAS const f32x4 gcf32x4;

__global__ void __launch_bounds__(NWAVES * 64, 2) fwd_kernel(Args args) {
    extern __shared__ __attribute__((aligned(16))) unsigned char lds[];
    LAS unsigned char* L = (LAS unsigned char*)lds;
    volatile LAS unsigned* MISC = (volatile LAS unsigned*)(L + MISC_OFF);
    const int G = gridDim.x; const int bx = blockIdx.x;
    const int wave_s = __builtin_amdgcn_readfirstlane(threadIdx.x >> 6);
    gu32* ctl = (gu32*)(args.ws + WS_CTL);
    for (int u = threadIdx.x; u < (LDS_BYTES - LDSCTL_OFF) / 4; u += NWAVES * 64) ((LAS unsigned*)(L + LDSCTL_OFF))[u] = 0u;
    __syncthreads();
    XcdBarrier bar; bar.bar = (unsigned*)(ctl + CW_BAR) + args.li * XCD_BAR_WORDS; bar.x = 0; bar.st = nullptr;
    if (!MK_PER_PHASE) bar = xcd_barrier_post((unsigned*)(ctl + CW_BAR) + args.li * XCD_BAR_WORDS, MISC + 8);
    const int lo = args.ph_lo, hi = args.ph_hi;
#define IN(k) (lo <= (k) && (k) < hi)
#define SEAM(k) do { if (IN(k) && IN((k) + 1)) xcd_barrier(bar); } while (0)
#define OPAQUE_S(p) asm volatile("" : "+s"(p))
#define PHASE_IDS() \
    int lane_; asm volatile("v_mbcnt_lo_u32_b32 %0, -1, 0\n\tv_mbcnt_hi_u32_b32 %0, -1, %0" : "=v"(lane_)); const int lane = lane_, wave = wave_s, tid = wave * 64 + lane; (void)tid; \
    const int vcu = (G % 8 == 0) ? (bx % 8) * (G / 8) + bx / 8 : bx; const int gw = vcu * NWAVES + wave, NGW = G * NWAVES; (void)lane; (void)gw; (void)NGW
#define PHASE_PTRS() \
    unsigned char* ws_ = args.ws; OPAQUE_S(ws_); GAS unsigned char* ws = (GAS unsigned char*)ws_; float* xres_ = args.out; OPAQUE_S(xres_); gf32* xres = (gf32*)xres_; \
    gf32* cs = (gf32*)(ws + WS_CS); gf32* stA = (gf32*)(ws + WS_STA); gf32* stB = (gf32*)(ws + WS_STB); gf32* ss = (gf32*)(ws + WS_SS); gf32* kmean = (gf32*)(ws + WS_KM); \
    gbf16* xb = (gbf16*)(ws + WS_XB); gbf16* QO = (gbf16*)(ws + WS_QO); gbf16* KB = (gbf16*)(ws + WS_KB); gbf16* VB = (gbf16*)(ws + WS_VB); gbf16* HB = (gbf16*)(ws + WS_H); \
    (void)cs; (void)stA; (void)stB; (void)ss; (void)kmean; (void)xb; (void)QO; (void)KB; (void)VB; (void)HB; (void)xres
#define LAYERW(l) LayerW{(gcf32*)args.in[1] + (size_t)(l) * DM, (gcf32*)args.in[2] + (size_t)(l) * DM * NQKV, (gcf32*)args.in[3] + (size_t)(l) * 512, (gcf32*)args.in[4] + (size_t)(l) * 512, \
                         (gcf32*)args.in[5] + (size_t)(l) * DM * DM, (gcf32*)args.in[6] + (size_t)(l) * DM, (gcf32*)args.in[7] + (size_t)(l) * DM * DFF, (gcf32*)args.in[8] + (size_t)(l) * DFF * DM}

    if (IN(0)) {
        PHASE_IDS(); PHASE_PTRS(); gcf32* x_in = (gcf32*)args.in[0];
        LAS float* scr = (LAS float*)(L + wave * 16384);
        for (int idx = bx * (NWAVES * 64) + tid; idx < SEQ * 32; idx += G * NWAVES * 64) {
            const int t = idx >> 5, i = idx & 31;
            const float inv = 1.0f / powf(10000.0f, (float)(2 * i) / 64.0f); const float ang = (float)t * inv;
            cs[idx] = cosf(ang); cs[SEQ * 32 + idx] = sinf(ang);
        }
        { const LayerW LW = LAYERW(0); convert_layer(LW, ws + WS_W, scr, gw, NGW, lane); }
        for (int row = gw; row < M; row += NGW) {
            gcf32x4* xr = (gcf32x4*)(x_in + (size_t)row * DM); float s = 0.f;
#pragma unroll
            for (int j = 0; j < 4; ++j) { const f32x4 v = xr[lane + 64 * j]; s += (v[0] * v[0] + v[1] * v[1]) + (v[2] * v[2] + v[3] * v[3]);
                v2u o; o.x = pk2(v[0], v[1]); o.y = pk2(v[2], v[3]); ((GAS v2u*)(xb + (size_t)row * DM))[lane + 64 * j] = o; }
            s = wave_sum(s);
            if (lane < 16) stA[(size_t)row * 16 + lane] = (lane == 0) ? s : 0.f;
        }
    }
    SEAM(0);

#pragma nounroll
    for (int l = 0; l < DEPTH; ++l) {
        const int p0 = 1 + l * PH_PER_LAYER;
        if (IN(p0)) {
            PHASE_PTRS(); GAS unsigned char* wb = ws + WS_W + (size_t)(l & 1) * W_BUF;
            pg8::Gemm g{(const bf16*)xb, (const bf16*)(wb + W_QKV), M, NQKV, DM}; pg8::StaticOrder S; S.init(M, NQKV, G, bx);
            pg8::EpiQKV E{QO, (size_t)(WS_KB - WS_QO) / 2, stA, cs, kmean};
            pg8::gemm_phase<pg8::EpiQKV, pg8::StaticOrder, true>(L, g, S, E, wave_s);
        }
        SEAM(p0);
        if (IN(p0 + 1)) {
            PHASE_IDS(); PHASE_PTRS();
            LAS float* scr = (LAS float*)(L + wave * 16384);
            if (l + 1 < DEPTH) { const LayerW LW = LAYERW(l + 1); convert_layer(LW, ws + WS_W + (size_t)((l + 1) & 1) * W_BUF, scr, gw, NGW, lane); }
        }
        SEAM(p0 + 1);
        if (IN(p0 + 2)) {
            PHASE_IDS(); PHASE_PTRS();
            static_assert(attn_body::ATTN_LDS_BYTES <= RING_BYTES, "attention scratch vs LDS ring");
            const int nun = (G == 256) ? 2 : (BATCH * 8 * 16 - vcu + G - 1) / G;
#pragma nounroll
            for (int i = 0; i < nun; ++i) {
                int bh, qb;
                if (G == 256) { bh = vcu >> 3; qb = (i == 0) ? 15 - (vcu & 7) : (vcu & 7); } else { const int u = vcu + i * G; bh = u >> 4; qb = u & 15; }
                attn_body::moba_unit<8>(bh >> 3, bh & 7, qb, SEQ, QO, KB, VB, QO, kmean, ss, (char*)lds, wave);
            }
            {
                char* wl = (char*)lds + wave * dil_body::WLDS; float* wsf = (float*)((char*)lds + RING_BYTES + 1024) + wave * 64;
                const int nit = (G == 256) ? 2 : (BATCH * 8 * 128 - gw + NGW - 1) / NGW;
#pragma nounroll
                for (int i = 0; i < nit; ++i) {
                    int bh, id;
                    if (G == 256) { bh = vcu >> 3; id = ((vcu & 7) * 8 + wave) + 64 * i; } else { const int it = gw + i * NGW; bh = it >> 7; id = it & 127; }
                    dil_body::dil_item<8>(bh >> 3, bh & 7, id >> 4, id & 15, SEQ, QO, KB, VB, QO, ss, wl, wsf);
                }
            }
        }
        SEAM(p0 + 2);
        if (IN(p0 + 3)) {
            PHASE_PTRS(); GAS unsigned char* wb = ws + WS_W + (size_t)(l & 1) * W_BUF; gcf32* x_in = (gcf32*)args.in[0];
            pg8::Gemm g{(const bf16*)QO, (const bf16*)(wb + W_O), M, DM, DM}; pg8::StaticOrder S; S.init(M, DM, G, bx);
            pg8::EpiRes<true> E{l == 0 ? x_in : (gcf32*)xres, xres, xb, stB, ss};
            pg8::gemm_phase<pg8::EpiRes<true>, pg8::StaticOrder, false>(L, g, S, E, wave_s);
        }
        SEAM(p0 + 3);
        if (IN(p0 + 4)) {
            PHASE_PTRS(); GAS unsigned char* wb = ws + WS_W + (size_t)(l & 1) * W_BUF;
            pg8::Gemm g{(const bf16*)xb, (const bf16*)(wb + W_UP), M, DFF, DM}; pg8::StaticOrder S; S.init(M, DFF, G, bx);
            pg8::EpiUp E{HB, stB};
            pg8::gemm_phase<pg8::EpiUp, pg8::StaticOrder, true>(L, g, S, E, wave_s);
        }
        SEAM(p0 + 4);
        if (IN(p0 + 5)) {
            PHASE_PTRS(); GAS unsigned char* wb = ws + WS_W + (size_t)(l & 1) * W_BUF;
            pg8::Gemm g{(const bf16*)HB, (const bf16*)(wb + W_DN), M, DM, DFF}; pg8::StaticOrder S; S.init(M, DM, G, bx);
            pg8::EpiRes<false> E{(gcf32*)xres, xres, xb, stA, nullptr};
            pg8::gemm_phase<pg8::EpiRes<false>, pg8::StaticOrder, false>(L, g, S, E, wave_s);
        }
        SEAM(p0 + 5);
    }
    if (IN(N_PHASES - 1)) {
        PHASE_IDS(); PHASE_PTRS(); gcf32* gfin = (gcf32*)args.in[9];
        for (int row = gw; row < M; row += NGW) {
            gf32x4* xr = (gf32x4*)(xres + (size_t)row * DM);
            const float r = pg8::row_rs(stA, row, 1.0f / DM);
#pragma unroll
            for (int j = 0; j < 4; ++j) { const f32x4 v = xr[lane + 64 * j]; const f32x4 gg = ((gcf32x4*)gfin)[lane + 64 * j]; xr[lane + 64 * j] = v * r * gg; }
        }
    }
#undef IN
#undef SEAM
}

extern "C" void kernel_launch(void* const* d_in, const int* in_sizes, int n_in, void* d_out, int out_size, void* d_ws, size_t ws_size, hipStream_t stream) {
    static int grid = 0;
    if (grid == 0) {
        if (n_in != 10 || out_size != M * DM || ws_size < WS_END) { fprintf(stderr, "kernel_launch: unexpected shapes (n_in %d out %d ws %zu)\n", n_in, out_size, ws_size); grid = -1; return; }
        int dev = 0, cus = 0, per_cu = 0;
        if (hipGetDevice(&dev) != hipSuccess || hipDeviceGetAttribute(&cus, hipDeviceAttributeMultiprocessorCount, dev) != hipSuccess) { grid = -1; return; }
        if (hipFuncSetAttribute((const void*)fwd_kernel, hipFuncAttributeMaxDynamicSharedMemorySize, LDS_BYTES) != hipSuccess) { fprintf(stderr, "kernel_launch: hipFuncSetAttribute failed\n"); grid = -1; return; }
        if (hipOccupancyMaxActiveBlocksPerMultiprocessor(&per_cu, (const void*)fwd_kernel, NWAVES * 64, LDS_BYTES) != hipSuccess || per_cu < 1)
            fprintf(stderr, "kernel_launch: note: occupancy query reports %d workgroups per CU\n", per_cu);
        (void)hipGetLastError();
        grid = cus;
    }
    if (grid < 0) return;
    if (hipMemsetAsync((char*)d_ws + WS_CTL, 0, CTL_ZERO_BYTES, stream) != hipSuccess) { fprintf(stderr, "kernel_launch: memset failed\n"); return; }
    Args a{};
    for (int i = 0; i < 10; ++i) a.in[i] = (const float*)d_in[i];
    a.out = (float*)d_out; a.ws = (unsigned char*)d_ws;
#if MK_PER_PHASE
    for (int p = 0; p < N_PHASES; ++p) { a.ph_lo = p; a.ph_hi = p + 1; a.li = 0; hipLaunchKernelGGL(fwd_kernel, dim3(grid), dim3(NWAVES * 64), LDS_BYTES, stream, a); }
#else
    a.ph_lo = 0; a.ph_hi = N_PHASES; a.li = 0;
    hipLaunchKernelGGL(fwd_kernel, dim3(grid), dim3(NWAVES * 64), LDS_BYTES, stream, a);
#endif
    const hipError_t le = hipPeekAtLastError();
    if (le != hipSuccess) fprintf(stderr, "kernel_launch: launch failed: %s\n", hipGetErrorName(le));
}
```

```cpp
#include <hip/hip_runtime.h>
#include <cstdio>
#include <cstdint>

#ifndef PROBE_PHASE
#define PROBE_PHASE -1
#endif
#ifndef MK_PER_PHASE
#define MK_PER_PHASE 0
#endif

constexpr int BATCH = 4, SEQ = 4096, DM = 1024, DEPTH = 4, DFF = 4096, M = BATCH * SEQ, NQKV = 3072;
constexpr float NORM_EPS = 1e-6f;
constexpr float C2 = 0.125f * 1.4426950408889634f;

namespace pg8 {
#define PG8_LAS __attribute__((address_space(3)))
typedef unsigned short bf16_t;
typedef short bf16x8 __attribute__((ext_vector_type(8)));
typedef float f32x4 __attribute__((ext_vector_type(4)));
typedef unsigned u32x4 __attribute__((ext_vector_type(4)));
#define PG8_GAS __attribute__((address_space(1)))
typedef PG8_GAS float gf32; typedef PG8_GAS const float gcf32; typedef PG8_GAS bf16_t gbf16;
typedef PG8_GAS f32x4 gf32x4; typedef PG8_GAS const f32x4 gcf32x4; typedef PG8_GAS u32x4 gu32x4;
constexpr int BM = 256, BK = 64, HALF = 128, HTB = HALF * BK * 2, STAGE_BYTES = 8 * HTB, NXCD = 8, WGM = 8;

__host__ __device__ __forceinline__ int lds_byte(int r, int c) { const int st = (r >> 4) * 2 + (c >> 5), rr = r & 15, cc = c & 31, ob = rr * 64 + cc * 2; return st * 1024 + (ob ^ (((ob >> 9) & 1) << 5)); }
__host__ __device__ __forceinline__ void stage_rc(int b, int& R, int& C) { const int st = b / 1024, sb = b % 1024, swz = sb ^ (((sb >> 9) & 1) << 5); R = (st >> 1) * 16 + swz / 64; C = (st & 1) * 32 + (swz % 64) / 2; }
__host__ __device__ __forceinline__ int perm32(int rho) { const int n = rho >> 4, i = rho & 15; return 8 * (i >> 2) + 4 * n + (i & 3); }

struct Unit { int pm, pn; };
struct Gemm { const bf16_t* A; const bf16_t* Bt; int M, N, K; };

struct StaticOrder {
    int nM, nN, nwg, G, c;
    __host__ __device__ void init(int M_, int N_, int G_, int c_) { nM = M_ / BM; nN = N_ / BM; nwg = nM * nN; G = G_; c = c_; }
    __host__ __device__ bool next(int i, Unit& u) const {
        const long L = (long)i * G + c; if (L >= nwg) return false;
        int wgid = (int)L; { const int q = nwg / NXCD, r = nwg % NXCD, xcd = wgid % NXCD, off = wgid / NXCD; wgid = (xcd < r ? xcd * (q + 1) : r * (q + 1) + (xcd - r) * q) + off; }
        const int nig = WGM * nN, gid = wgid / nig, fm = gid * WGM, gsz = (nM - fm) < WGM ? (nM - fm) : WGM;
        u.pm = fm + ((wgid % nig) % gsz); u.pn = (wgid % nig) / gsz; return true;
    }
    __device__ __forceinline__ void a_ready(const Unit&) const {}
    __device__ __forceinline__ void done(const Unit&) const {}
};

__device__ __forceinline__ unsigned cvt_pk_bf16(float lo, float hi) { unsigned r; asm volatile("v_cvt_pk_bf16_f32 %0, %1, %2" : "=v"(r) : "v"(lo), "v"(hi)); return r; }

__device__ __forceinline__ int lane_id_now() { int l; asm volatile("v_mbcnt_lo_u32_b32 %0, -1, 0\n\tv_mbcnt_hi_u32_b32 %0, -1, %0" : "=v"(l)); return l; }
#define PG8_FRESH_LANE() const int lane_f = lane_id_now(), fr = lane_f & 15, fq = lane_f >> 4
__device__ __forceinline__ float row_rs(gcf32* stats, int row, float inv_n) {
    gcf32x4* p = (gcf32x4*)(stats + (size_t)row * 16);
    const f32x4 a = p[0], b = p[1], c = p[2], d = p[3];
    const float s = ((a[0] + a[1]) + (a[2] + a[3])) + ((b[0] + b[1]) + (b[2] + b[3])) + ((c[0] + c[1]) + (c[2] + c[3])) + ((d[0] + d[1]) + (d[2] + d[3]));
    return 1.0f / sqrtf(s * inv_n + NORM_EPS);
}


struct EpiQKV {
    static constexpr bool PERM = true, AFTER_DRAIN = false, MID = false;
    gbf16* Q; size_t arr_stride; gcf32* stats; gcf32* cs; gf32* kpart;
    __device__ __forceinline__ void mid(f32x4 (&)[2][2][4][2], const Unit&, int, int, int, int) const {}
    __device__ __forceinline__ void operator()(const f32x4 (&acc)[2][2][4][2], const Unit& u, int wr, int wc, int, int) const {
        PG8_FRESH_LANE();
        const int arr = u.pn >> 2;
        gbf16* base = Q + (size_t)arr * arr_stride;
        const int col0 = (u.pn & 3) * 256 + 64 * wc + 8 * fq;
        const float qs = arr == 0 ? C2 : 1.0f;
        const bool ksum = (arr == 1) && ((u.pn & 3) < 2);
        f32x4 cs0 = {0.f, 0.f, 0.f, 0.f}, cs1 = cs0, cs2 = cs0, cs3 = cs0;
#pragma unroll
        for (int ai = 0; ai < 2; ++ai)
#pragma unroll
            for (int m = 0; m < 4; ++m) {
                const int row = u.pm * BM + ai * HALF + wr * 64 + m * 16 + fr;
                const float rs = row_rs(stats, row, 1.0f / DM) * qs;
                f32x4 l0 = acc[ai][0][m][0] * rs, l1 = acc[ai][0][m][1] * rs, h0 = acc[ai][1][m][0] * rs, h1 = acc[ai][1][m][1] * rs;
                if (arr < 2) {
                    const int t = row & (SEQ - 1);
                    const f32x4 c0 = *(gcf32x4*)(cs + t * 32 + 8 * fq), c1 = *(gcf32x4*)(cs + t * 32 + 8 * fq + 4);
                    const f32x4 s0 = *(gcf32x4*)(cs + SEQ * 32 + t * 32 + 8 * fq), s1 = *(gcf32x4*)(cs + SEQ * 32 + t * 32 + 8 * fq + 4);
                    const f32x4 o0 = l0 * c0 - h0 * s0, o1 = l1 * c1 - h1 * s1, p0 = h0 * c0 + l0 * s0, p1 = h1 * c1 + l1 * s1;
                    l0 = o0; l1 = o1; h0 = p0; h1 = p1;
                }
                cs0 += l0; cs1 += l1; cs2 += h0; cs3 += h1;
                gbf16* rowp = base + (size_t)row * DM + col0;
                u32x4 w; w.x = cvt_pk_bf16(l0[0], l0[1]); w.y = cvt_pk_bf16(l0[2], l0[3]); w.z = cvt_pk_bf16(l1[0], l1[1]); w.w = cvt_pk_bf16(l1[2], l1[3]);
                *(gu32x4*)rowp = w;
                w.x = cvt_pk_bf16(h0[0], h0[1]); w.y = cvt_pk_bf16(h0[2], h0[3]); w.z = cvt_pk_bf16(h1[0], h1[1]); w.w = cvt_pk_bf16(h1[2], h1[3]);
                *(gu32x4*)(rowp + 32) = w;
                if (m & 1) asm volatile("" ::: "memory");
            }
        if (ksum) {
#pragma unroll
            for (int o = 1; o < 16; o <<= 1)
#pragma unroll
                for (int i = 0; i < 4; ++i) { cs0[i] += __shfl_xor(cs0[i], o); cs1[i] += __shfl_xor(cs1[i], o); cs2[i] += __shfl_xor(cs2[i], o); cs3[i] += __shfl_xor(cs3[i], o); }
            if (fr == 0) {
                const int b = u.pm >> 4, j = u.pm & 15, head = (u.pn & 3) * 4 + wc;
                gf32* kp = kpart + ((size_t)((b * 8 + head) * 16 + j) * 2 + wr) * 64 + 8 * fq;
                *(gf32x4*)kp = cs0; *(gf32x4*)(kp + 4) = cs1; *(gf32x4*)(kp + 32) = cs2; *(gf32x4*)(kp + 36) = cs3;
            }
        }
    }
};

struct EpiUp {
    static constexpr bool PERM = true, AFTER_DRAIN = false, MID = false;
    gbf16* H; gcf32* stats;
    __device__ __forceinline__ void mid(f32x4 (&)[2][2][4][2], const Unit&, int, int, int, int) const {}
    __device__ __forceinline__ void operator()(const f32x4 (&acc)[2][2][4][2], const Unit& u, int wr, int wc, int, int) const {
        PG8_FRESH_LANE();
        const int col0 = u.pn * BM + wc * 32 + 8 * fq;
#pragma unroll
        for (int ai = 0; ai < 2; ++ai)
#pragma unroll
            for (int m = 0; m < 4; ++m) {
                const int row = u.pm * BM + ai * HALF + wr * 64 + m * 16 + fr;
                const float rs = row_rs(stats, row, 1.0f / DM);
                gbf16* rowp = H + (size_t)row * DFF + col0;
#pragma unroll
                for (int bj = 0; bj < 2; ++bj) {
                    f32x4 v0 = acc[ai][bj][m][0] * rs, v1 = acc[ai][bj][m][1] * rs;
#pragma unroll
                    for (int i = 0; i < 4; ++i) { const float a = fmaxf(v0[i], 0.f), b = fmaxf(v1[i], 0.f); v0[i] = a * a; v1[i] = b * b; }
                    u32x4 w; w.x = cvt_pk_bf16(v0[0], v0[1]); w.y = cvt_pk_bf16(v0[2], v0[3]); w.z = cvt_pk_bf16(v1[0], v1[1]); w.w = cvt_pk_bf16(v1[2], v1[3]);
                    *(gu32x4*)(rowp + bj * HALF) = w;
                }
                if (m & 1) asm volatile("" ::: "memory");
            }
    }
};

struct EpiNull {
    static constexpr bool PERM = true, AFTER_DRAIN = false, MID = false;
    gf32* dummy;
    __device__ __forceinline__ void mid(f32x4 (&)[2][2][4][2], const Unit&, int, int, int, int) const {}
    __device__ __forceinline__ void operator()(const f32x4 (&acc)[2][2][4][2], const Unit& u, int wr, int wc, int, int) const {
        f32x4 t = {0.f, 0.f, 0.f, 0.f};
#pragma unroll
        for (int ai = 0; ai < 2; ++ai)
#pragma unroll
            for (int bj = 0; bj < 2; ++bj)
#pragma unroll
                for (int m = 0; m < 4; ++m)
#pragma unroll
                    for (int n = 0; n < 2; ++n) t += acc[ai][bj][m][n];
        const float v = (t[0] + t[1]) + (t[2] + t[3]);
        if (v == 12345.678f) dummy[u.pm * 4 + u.pn] = v;
    }
};

template <bool TWO_SCALE> struct EpiRes {
    static constexpr bool PERM = true, AFTER_DRAIN = false, MID = TWO_SCALE;
    gbf16* xb; gf32* stats_out; gcf32* ss;
    __device__ __forceinline__ void half_scales(int row, float& ra, float& rd) const {
        gcf32x4* p = (gcf32x4*)(ss + (size_t)row * 16);
        const f32x4 a = p[0], b = p[1], c = p[2], d = p[3];
        const float sa = ((a[0] + a[1]) + (a[2] + a[3])) + ((b[0] + b[1]) + (b[2] + b[3])), sd = ((c[0] + c[1]) + (c[2] + c[3])) + ((d[0] + d[1]) + (d[2] + d[3]));
        ra = 1.0f / sqrtf(sa * (1.0f / 512.0f) + NORM_EPS); rd = 1.0f / sqrtf(sd * (1.0f / 512.0f) + NORM_EPS);
    }
    __device__ __forceinline__ void mid(f32x4 (&acc)[2][2][4][2], const Unit& u, int wr, int wc, int, int) const {
        if constexpr (TWO_SCALE) {
            PG8_FRESH_LANE(); (void)fq;
#pragma unroll
            for (int ai = 0; ai < 2; ++ai)
#pragma unroll
                for (int m = 0; m < 4; ++m) {
                    const int row = u.pm * BM + ai * HALF + wr * 64 + m * 16 + fr; float ra, rd; half_scales(row, ra, rd); const float f = ra / rd;
#pragma unroll
                    for (int bj = 0; bj < 2; ++bj)
#pragma unroll
                        for (int n = 0; n < 2; ++n) acc[ai][bj][m][n] = acc[ai][bj][m][n] * f;
                    if (m & 1) asm volatile("" ::: "memory");
                }
        }
    }
    __device__ __forceinline__ void operator()(const f32x4 (&acc)[2][2][4][2], const Unit& u, int wr, int wc, int, int) const {
        PG8_FRESH_LANE();
        const int col0 = u.pn * BM + wc * 32 + 8 * fq;
#pragma unroll
        for (int ai = 0; ai < 2; ++ai)
#pragma unroll
            for (int m = 0; m < 4; ++m) {
                const int row = u.pm * BM + ai * HALF + wr * 64 + m * 16 + fr;
                float rd = 1.0f; if constexpr (TWO_SCALE) { float ra; half_scales(row, ra, rd); }
                const size_t off = (size_t)row * DM + col0; float sq = 0.f;
#pragma unroll
                for (int bj = 0; bj < 2; ++bj) {
                    const u32x4 bw = *(gu32x4*)(xb + off + bj * HALF);
                    const f32x4 b0 = {__builtin_bit_cast(float, bw.x << 16), __builtin_bit_cast(float, bw.x & 0xffff0000u), __builtin_bit_cast(float, bw.y << 16), __builtin_bit_cast(float, bw.y & 0xffff0000u)};
                    const f32x4 b1 = {__builtin_bit_cast(float, bw.z << 16), __builtin_bit_cast(float, bw.z & 0xffff0000u), __builtin_bit_cast(float, bw.w << 16), __builtin_bit_cast(float, bw.w & 0xffff0000u)};
                    const f32x4 x0 = b0 + acc[ai][bj][m][0] * rd, x1 = b1 + acc[ai][bj][m][1] * rd;
                    sq += ((x0[0] * x0[0] + x0[1] * x0[1]) + (x0[2] * x0[2] + x0[3] * x0[3])) + ((x1[0] * x1[0] + x1[1] * x1[1]) + (x1[2] * x1[2] + x1[3] * x1[3]));
                    u32x4 w; w.x = cvt_pk_bf16(x0[0], x0[1]); w.y = cvt_pk_bf16(x0[2], x0[3]); w.z = cvt_pk_bf16(x1[0], x1[1]); w.w = cvt_pk_bf16(x1[2], x1[3]);
                    *(gu32x4*)(xb + off + bj * HALF) = w;
                }
                sq += __shfl_xor(sq, 16); sq += __shfl_xor(sq, 32);
                if (fq == 0) stats_out[(size_t)row * 16 + u.pn * 4 + wc] = sq;
                asm volatile("" ::: "memory");
            }
    }
};

template <class Epi, class Sched, bool ALIGN_EPI>
__device__ __forceinline__ void gemm_phase(PG8_LAS unsigned char* lds, const Gemm g, const Sched& S, const Epi& E, const int wid_  ) {
    int lane_; asm volatile("v_mbcnt_lo_u32_b32 %0, -1, 0\n\tv_mbcnt_hi_u32_b32 %0, -1, %0" : "=v"(lane_));
    int wid_o = wid_; asm volatile("" : "+s"(wid_o));
    const int lane = lane_, wid = wid_o, tid = wid * 64 + lane, wr = wid >> 2, wc = wid & 3, fr = lane & 15, fq = lane >> 4;
    const int K = g.K, nt = K / BK;
    unsigned voffA[2], voffB[2];
#pragma unroll
    for (int i = 0; i < 2; ++i) { int R, C; stage_rc(tid * 16 + i * 8192, R, C); const int Rb = Epi::PERM ? ((R & ~31) + perm32(R & 31)) : R;
        voffA[i] = (unsigned)(R * K + C) * 2u; voffB[i] = (unsigned)(Rb * K + C) * 2u; }
    const size_t kstep = (size_t)(BK * 2);
    const size_t hstep = (size_t)HALF * K * 2;
    const size_t tstep = 2 * hstep;
    const unsigned ldsw = (unsigned)wid * 1024u;
    const int aoff = lds_byte(wr * 64 + fr, fq * 8), boff = lds_byte(wc * 32 + fr, fq * 8);
#define PG8_SA(b, h) (((b) * 2 + (h)) * HTB)
#define PG8_SB(b, h) ((4 + (b) * 2 + (h)) * HTB)
#define PG8_STAGE(bufoff, gbase, voff) do { _Pragma("unroll") for (int _i = 0; _i < 2; ++_i) \
        __builtin_amdgcn_global_load_lds((const unsigned*)((const char*)(gbase) + (voff)[_i]), (PG8_LAS unsigned*)(lds + (bufoff) + ldsw + _i * 8192), 16, 0, 0); } while (0)
#define PG8_LDA(dst, b, h) do { _Pragma("unroll") for (int m = 0; m < 4; ++m) _Pragma("unroll") for (int k = 0; k < 2; ++k) dst[m][k] = *(const PG8_LAS bf16x8*)(lds + PG8_SA(b, h) + aoff + m * 2048 + k * 1024); } while (0)
#define PG8_LDB(dst, b, h) do { _Pragma("unroll") for (int n = 0; n < 2; ++n) _Pragma("unroll") for (int k = 0; k < 2; ++k) dst[n][k] = *(const PG8_LAS bf16x8*)(lds + PG8_SB(b, h) + boff + n * 2048 + k * 1024); } while (0)
#define PG8_MMA(ai, bj, At, Bt) do { __builtin_amdgcn_s_setprio(1); _Pragma("unroll") for (int m = 0; m < 4; ++m) _Pragma("unroll") for (int n = 0; n < 2; ++n) _Pragma("unroll") for (int k = 0; k < 2; ++k) \
        acc[ai][bj][m][n] = __builtin_amdgcn_mfma_f32_16x16x32_bf16(Bt[n][k], At[m][k], acc[ai][bj][m][n], 0, 0, 0); __builtin_amdgcn_s_setprio(0); } while (0)
#define PG8_WAIT_V(n) asm volatile("s_waitcnt vmcnt(" #n ")" ::: "memory")
#define PG8_WAIT_L(n) asm volatile("s_waitcnt lgkmcnt(" #n ")" ::: "memory")
#define PG8_BAR __builtin_amdgcn_s_barrier()
#define PG8_SCHED __builtin_amdgcn_sched_barrier(0)
    Unit cur, nxt; int ui = 0;
    if (!S.next(0, cur)) return;
    f32x4 acc[2][2][4][2];
#pragma unroll
    for (int a = 0; a < 2; ++a)
#pragma unroll
        for (int b = 0; b < 2; ++b)
#pragma unroll
            for (int m = 0; m < 4; ++m)
#pragma unroll
                for (int n = 0; n < 2; ++n) acc[a][b][m][n] = (f32x4){0.f, 0.f, 0.f, 0.f};
    bf16x8 At[4][2], B0[2][2], B1[2][2];
    const char* cA = (const char*)g.A + (size_t)cur.pm * tstep; const char* cB = (const char*)g.Bt + (size_t)cur.pn * tstep;
    S.a_ready(cur);
    PG8_STAGE(PG8_SB(0, 0), cB, voffB); PG8_STAGE(PG8_SB(0, 1), cB + hstep, voffB); PG8_STAGE(PG8_SA(0, 0), cA, voffA); PG8_STAGE(PG8_SA(0, 1), cA + hstep, voffA);
    if (wr == 1) PG8_BAR;
    PG8_WAIT_V(2); PG8_BAR;
    PG8_STAGE(PG8_SB(1, 0), cB + kstep, voffB); PG8_STAGE(PG8_SA(1, 0), cA + kstep, voffA); PG8_STAGE(PG8_SB(1, 1), cB + hstep + kstep, voffB);
    PG8_WAIT_V(6); PG8_BAR;
    for (;;) {
        const bool has_next = S.next(ui + 1, nxt);
        const char* nA = has_next ? (const char*)g.A + (size_t)nxt.pm * tstep : cA; const char* nB = has_next ? (const char*)g.Bt + (size_t)nxt.pn * tstep : cB;
        for (int t = 0; t < nt; t += 2) {
            if constexpr (Epi::MID) { if (t == (nt >> 1)) { E.mid(acc, cur, wr, wc, fr, fq); PG8_SCHED; } }
            const bool last = (t == nt - 2);
            const char* a1 = cA + (size_t)(t + 1) * kstep;
            const char* a2 = last ? nA : cA + (size_t)(t + 2) * kstep; const char* b2 = last ? nB : cB + (size_t)(t + 2) * kstep;
            const char* a3 = a2 + kstep; const char* b3 = b2 + kstep;
            if (last && has_next) S.a_ready(nxt);
            PG8_LDB(B0, 0, 0); PG8_LDB(B1, 0, 1); PG8_SCHED; PG8_LDA(At, 0, 0); PG8_STAGE(PG8_SA(1, 1), a1 + hstep, voffA);
            PG8_WAIT_V(8); PG8_WAIT_L(0); PG8_BAR; PG8_MMA(0, 0, At, B0); PG8_MMA(0, 1, At, B1); PG8_BAR; PG8_SCHED;
            PG8_LDA(At, 0, 1); PG8_STAGE(PG8_SB(0, 0), b2, voffB); PG8_STAGE(PG8_SB(0, 1), b2 + hstep, voffB); PG8_STAGE(PG8_SA(0, 0), a2, voffA);
            PG8_WAIT_V(8); PG8_WAIT_L(0); PG8_BAR; PG8_MMA(1, 0, At, B0); PG8_MMA(1, 1, At, B1); PG8_BAR; PG8_SCHED;
            PG8_LDB(B0, 1, 0); PG8_LDB(B1, 1, 1); PG8_SCHED; PG8_LDA(At, 1, 0); PG8_STAGE(PG8_SA(0, 1), a2 + hstep, voffA);
            PG8_WAIT_V(8); PG8_WAIT_L(0); PG8_BAR; PG8_MMA(0, 0, At, B0); PG8_MMA(0, 1, At, B1); PG8_BAR; PG8_SCHED;
            PG8_LDA(At, 1, 1); PG8_STAGE(PG8_SB(1, 0), b3, voffB); PG8_STAGE(PG8_SB(1, 1), b3 + hstep, voffB); PG8_STAGE(PG8_SA(1, 0), a3, voffA);
            PG8_WAIT_V(8); PG8_WAIT_L(0); PG8_BAR; PG8_MMA(1, 0, At, B0); PG8_MMA(1, 1, At, B1); PG8_BAR; PG8_SCHED;
        }
        if constexpr (ALIGN_EPI) { if (wr == 0) PG8_BAR; }
        E(acc, cur, wr, wc, fr, fq); S.done(cur);
        if (!has_next) break;
#pragma unroll
        for (int a = 0; a < 2; ++a)
#pragma unroll
            for (int b = 0; b < 2; ++b)
#pragma unroll
                for (int m = 0; m < 4; ++m)
#pragma unroll
                    for (int n = 0; n < 2; ++n) acc[a][b][m][n] = (f32x4){0.f, 0.f, 0.f, 0.f};
        cur = nxt; cA = nA; cB = nB; ++ui;
        if constexpr (ALIGN_EPI) { if (wr == 1) PG8_BAR; }
    }
    PG8_WAIT_V(0);
    if constexpr (!ALIGN_EPI) { if (wr == 0) PG8_BAR; }
    PG8_BAR;
#undef PG8_SA
#undef PG8_SB
#undef PG8_STAGE
#undef PG8_LDA
#undef PG8_LDB
#undef PG8_MMA
#undef PG8_WAIT_V
#undef PG8_WAIT_L
#undef PG8_BAR
#undef PG8_SCHED
}
}

namespace attn_body {
using bf16x8=__attribute__((ext_vector_type(8)))short;
using s16x4=__attribute__((ext_vector_type(4)))short;
using f32x16=__attribute__((ext_vector_type(16)))float;
using u32x4=__attribute__((ext_vector_type(4)))unsigned;
using f32x4=__attribute__((ext_vector_type(4)))float;
typedef unsigned short bf16;
#define AGAS __attribute__((address_space(1)))
constexpr int D=64,DMP=1024;
constexpr int NW=8,QBLK=32,QB=QBLK*NW,KVBLK=64;
__device__ __forceinline__ int crow(int r,int hi){return (r&3)+8*(r>>2)+4*hi;}
#define SBAR() __builtin_amdgcn_sched_barrier(0)
__device__ __forceinline__ void cmask(f32x16&p0,f32x16&p1,int jb,int qrel,int hi){
  const float NEG=-INFINITY; int kb=64*jb+4*hi;
  #pragma unroll
  for(int r=0;r<16;++r){int kv=kb+(r&3)+8*(r>>2); if(kv>qrel)p0[r]=NEG; if(kv+32>qrel)p1[r]=NEG;}
}
constexpr int NSLOT=3, SLOTB=8192;
constexpr int LDS_K=0, LDS_V=NSLOT*SLOTB, LDS_WS=2*NSLOT*SLOTB, LDS_OST=LDS_WS+NW*64*4, LDS_BYTES=LDS_OST+NW*4096;
__device__ __forceinline__ void glds16(const void*gsrc,unsigned lds_dst){unsigned keep;
  asm volatile("s_mov_b32 %0, m0\n\ts_mov_b32 m0, %2\n\ts_nop 0\n\tglobal_load_lds_dwordx4 %1, off\n\ts_mov_b32 m0, %0":"=&s"(keep):"v"(gsrc),"s"(lds_dst):"memory");}
__device__ __forceinline__ float max3f(float a,float b,float c){float r;asm("v_max3_f32 %0, %1, %2, %3":"=v"(r):"v"(a),"v"(b),"v"(c));return r;}
__device__ __forceinline__ float max2f(float a,float b){float r;asm("v_max_f32_e32 %0, %1, %2":"=v"(r):"v"(a),"v"(b));return r;}
__device__ __forceinline__ float fadd_s(float a,float b){float r;asm("v_add_f32_e32 %0, %1, %2":"=v"(r):"v"(a),"v"(b));return r;}
__device__ __forceinline__ float fsub_s(float a,float b){float r;asm("v_sub_f32_e32 %0, %1, %2":"=v"(r):"v"(a),"v"(b));return r;}
typedef float f32x2_t __attribute__((ext_vector_type(2))); typedef __bf16 bf16x2_t __attribute__((ext_vector_type(2)));
__device__ __forceinline__ unsigned cvtpk_s(float lo,float hi){f32x2_t v={lo,hi};bf16x2_t b=__builtin_convertvector(v,bf16x2_t);return __builtin_bit_cast(unsigned,b);}
#define WAIT_BAR(N) asm volatile("s_waitcnt vmcnt(" #N ") lgkmcnt(0)\n\ts_barrier":::"memory")
__device__ __forceinline__ void qkt(f32x16&p0,f32x16&p1,const char*Kslot,const bf16x8*qr,const f32x16&negm,int r32,int hi){
  const char*kb=Kslot+(r32>>3)*1024+((hi^((r32>>3)&1))*128)+(r32&7)*16;
  #pragma unroll
  for(int d0=0;d0<4;++d0){
    const bf16x8 b0=*reinterpret_cast<const bf16x8*>(kb+d0*256);
    const bf16x8 b1=*reinterpret_cast<const bf16x8*>(kb+d0*256+4096);
    if(d0==0){p0=__builtin_amdgcn_mfma_f32_32x32x16_bf16(b0,qr[0],negm,0,0,0);p1=__builtin_amdgcn_mfma_f32_32x32x16_bf16(b1,qr[0],negm,0,0,0);}
    else{p0=__builtin_amdgcn_mfma_f32_32x32x16_bf16(b0,qr[d0],p0,0,0,0);p1=__builtin_amdgcn_mfma_f32_32x32x16_bf16(b1,qr[d0],p1,0,0,0);}}
}
typedef __attribute__((address_space(3))) const char* lds_cptr;
typedef short v4i16_t __attribute__((ext_vector_type(4)));
__device__ __forceinline__ void kload8(bf16x8*kf,lds_cptr kp){
  kf[0]=*(const __attribute__((address_space(3))) bf16x8*)(kp);      kf[1]=*(const __attribute__((address_space(3))) bf16x8*)(kp+4096);
  kf[2]=*(const __attribute__((address_space(3))) bf16x8*)(kp+256);  kf[3]=*(const __attribute__((address_space(3))) bf16x8*)(kp+4352);
  kf[4]=*(const __attribute__((address_space(3))) bf16x8*)(kp+512);  kf[5]=*(const __attribute__((address_space(3))) bf16x8*)(kp+4608);
  kf[6]=*(const __attribute__((address_space(3))) bf16x8*)(kp+768);  kf[7]=*(const __attribute__((address_space(3))) bf16x8*)(kp+4864);
}
__device__ __forceinline__ void kload2(bf16x8*kf,lds_cptr kp,int j){ kf[2*j]=*(const __attribute__((address_space(3))) bf16x8*)(kp+j*256); kf[2*j+1]=*(const __attribute__((address_space(3))) bf16x8*)(kp+j*256+4096); }
__device__ __forceinline__ s16x4 vtr(lds_cptr p){ return __builtin_bit_cast(s16x4,__builtin_amdgcn_ds_read_tr16_b64_v4i16((__attribute__((address_space(3))) v4i16_t*)p)); }
__device__ __forceinline__ float rowmax(const f32x16&p0,const f32x16&p1){
  float a=max3f(p0[0],p0[1],p1[0]),b=max3f(p0[2],p0[3],p1[1]);a=max3f(a,p1[2],p1[3]);
  #pragma unroll
  for(int r=4;r<16;r+=4){a=max3f(a,p0[r],p0[r+1]);b=max3f(b,p0[r+2],p0[r+3]);a=max3f(a,p1[r],p1[r+1]);b=max3f(b,p1[r+2],p1[r+3]);}
  const float m=max2f(a,b);
  auto rr=__builtin_amdgcn_permlane32_swap(__float_as_uint(m),__float_as_uint(m),false,false);
  return max2f(__uint_as_float(rr[0]),__uint_as_float(rr[1]));
}
__device__ __forceinline__ void pv(f32x16*o,int vb,bf16x8 pa0,bf16x8 pa1,bf16x8 pa2,bf16x8 pa3){
  #pragma unroll
  for(int d0=0;d0<2;++d0){s16x4 lo[4],hi[4];
    #pragma unroll
    for(int ks=0;ks<4;++ks){
      asm volatile("ds_read_b64_tr_b16 %0,%1 offset:%c2":"=&v"(lo[ks]):"v"(vb),"i"(d0*512+ks*2048):"memory");
      asm volatile("ds_read_b64_tr_b16 %0,%1 offset:%c2":"=&v"(hi[ks]):"v"(vb),"i"(d0*512+ks*2048+1024):"memory");}
    asm volatile("s_waitcnt lgkmcnt(0)":::"memory");SBAR();
    #define PK(k) (bf16x8){lo[k][0],lo[k][1],lo[k][2],lo[k][3],hi[k][0],hi[k][1],hi[k][2],hi[k][3]}
    o[d0]=__builtin_amdgcn_mfma_f32_32x32x16_bf16(pa0,PK(0),o[d0],0,0,0);
    o[d0]=__builtin_amdgcn_mfma_f32_32x32x16_bf16(pa1,PK(1),o[d0],0,0,0);
    o[d0]=__builtin_amdgcn_mfma_f32_32x32x16_bf16(pa2,PK(2),o[d0],0,0,0);
    o[d0]=__builtin_amdgcn_mfma_f32_32x32x16_bf16(pa3,PK(3),o[d0],0,0,0);
    #undef PK
  }
}
__device__ __forceinline__ int lane_now(){ int l; asm volatile("v_mbcnt_lo_u32_b32 %0, -1, 0\n\tv_mbcnt_hi_u32_b32 %0, -1, %0":"=v"(l)); return l; }
__device__ __forceinline__ unsigned short f2bf_s(float f){ unsigned u=__builtin_bit_cast(unsigned,f); return (unsigned short)((u+0x7fffu+((u>>16)&1u))>>16); }

template<int THRL> __device__ __forceinline__ void moba_unit(int b,int h,int qb,int SEQL,AGAS const bf16*Q,AGAS const bf16*K,AGAS const bf16*V,AGAS bf16*O,AGAS const float*kpart,AGAS float*ss,char*shm,const int wid){
  int lane_; asm volatile("v_mbcnt_lo_u32_b32 %0, -1, 0\n\tv_mbcnt_hi_u32_b32 %0, -1, %0":"=v"(lane_));
  const int lane=lane_,r32=lane&31,hi=lane>>5;
  const long rowbase=(long)b*SEQL; const int q0=qb*QB;
  AGAS const bf16*Qw=Q+(rowbase+q0+wid*QBLK)*DMP+h*D;
  AGAS const bf16*Kh=K+rowbase*DMP+h*D; AGAS const bf16*Vh=V+rowbase*DMP+h*D;
  const unsigned lds0=(unsigned)(uintptr_t)shm;
  float*wsf=(float*)(shm+LDS_WS)+wid*64;
  AGAS const bf16*ksrc=Kh+(long)(8*wid+(lane&7))*DMP+(((lane>>3)^(wid&1))*8);
  AGAS const bf16*vsrc=Vh+(long)(8*wid+((lane>>2)&7))*DMP+(lane>>5)*32+(lane&3)*8;
  const unsigned kdst=lds0+LDS_K+wid*1024, vdst=lds0+LDS_V+wid*1024;
  #define DMA_K(t,slot) glds16((const void*)(ksrc+(long)(t)*KVBLK*DMP),(unsigned)__builtin_amdgcn_readfirstlane(kdst+(slot)))
  #define DMA_V(t,slot) glds16((const void*)(vsrc+(long)(t)*KVBLK*DMP),(unsigned)__builtin_amdgcn_readfirstlane(vdst+(slot)))
  const char*Kbase=shm+LDS_K; bf16x8 kf[8];
  const lds_cptr shm3=(lds_cptr)shm; const lds_cptr kp0=shm3+LDS_K+(r32>>3)*1024+((hi^((r32>>3)&1))*128)+(r32&7)*16; const lds_cptr vp0=shm3+LDS_V+((lane>>4)&1)*32+(lane&3)*8+(4*hi+((lane&15)>>2))*64;
  const int NT=(q0+QB)/KVBLK;
  DMA_K(0,0);DMA_V(0,0);DMA_K(1,SLOTB);
  bf16x8 qr[4];
  #pragma unroll
  for(int d0=0;d0<4;++d0)qr[d0]=*reinterpret_cast<AGAS const bf16x8*>(&Qw[(long)r32*DMP+d0*16+hi*8]);
  unsigned selbits=1u<<qb;
  if(qb>0){
    f32x16 g=f32x16{};
    { AGAS const float*kp=kpart+((size_t)((b*8+h)*16+(r32&15))*2)*64+8*hi;
      #pragma unroll
      for(int d0=0;d0<4;++d0){
        f32x4 a0=*(AGAS const f32x4*)(kp+16*d0),a1=*(AGAS const f32x4*)(kp+16*d0+4),c0=*(AGAS const f32x4*)(kp+64+16*d0),c1=*(AGAS const f32x4*)(kp+64+16*d0+4);
        a0=(a0+c0)*(1.0f/256.0f); a1=(a1+c1)*(1.0f/256.0f);
        if(r32>=16){a0=f32x4{0.f,0.f,0.f,0.f};a1=a0;}
        bf16x8 kh,kl;
        #pragma unroll
        for(int i=0;i<4;++i){ const unsigned short h0=f2bf_s(a0[i]),h1=f2bf_s(a1[i]); kh[i]=(short)h0; kh[4+i]=(short)h1;
          kl[i]=(short)f2bf_s(a0[i]-__builtin_bit_cast(float,(unsigned)h0<<16)); kl[4+i]=(short)f2bf_s(a1[i]-__builtin_bit_cast(float,(unsigned)h1<<16)); }
        g=__builtin_amdgcn_mfma_f32_32x32x16_bf16(kh,qr[d0],g,0,0,0);
        g=__builtin_amdgcn_mfma_f32_32x32x16_bf16(kl,qr[d0],g,0,0,0);
      } }
    float gv[16];
    #pragma unroll
    for(int r=0;r<8;++r){ auto rr=__builtin_amdgcn_permlane32_swap(__float_as_uint(g[r]),__float_as_uint(g[r]),false,false);
      const int j0=(r&3)+8*(r>>2); gv[j0]=(j0<qb)?__uint_as_float(rr[0]):-1e30f; gv[j0+4]=(j0+4<qb)?__uint_as_float(rr[1]):-1e30f; }
    unsigned sel=0u;
    #pragma unroll
    for(int rep=0;rep<3;++rep){ float best=-INFINITY; int bi=0;
      #pragma unroll
      for(int j=0;j<16;++j){ const bool ok=!((sel>>j)&1u); if(ok&&gv[j]>best){best=gv[j];bi=j;} }
      sel|=1u<<bi; }
    selbits=(sel&((1u<<qb)-1u))|(1u<<qb);
  }
  #define MASKOF(tt) ((unsigned)(-(int)((selbits>>((tt)>>2))&1u)))
  #define SELOF(tt) (((selbits>>((tt)>>2))&1u)!=0u)
  float mhat=0.f,l_reg=0.f;f32x16 o[2];o[0]=f32x16{};o[1]=f32x16{};f32x16 negm=f32x16{};asm volatile("":"+v"(negm));
  const int qrel=wid*QBLK+r32;
  #define CMASK(P0,P1,t) do{int jb_=(t)-(NT-4); if(jb_>=0)cmask(P0,P1,jb_,qrel,hi);}while(0)
  bool resc=false;
  #define START(P0,P1) do{ const float rm=rowmax(P0,P1); resc=false; \
    { const float dl=rm; mhat=fadd_s(mhat,dl); \
      _Pragma("unroll") for(int r=0;r<16;++r){P0[r]=fsub_s(P0[r],dl);P1[r]=fsub_s(P1[r],dl);} \
      _Pragma("unroll") for(int r=0;r<16;++r)negm[r]=-mhat; asm volatile("":"+v"(negm)); } \
    _Pragma("unroll") for(int r=0;r<16;++r)P0[r]=__builtin_amdgcn_exp2f(P0[r]); }while(0)
  #define RESC() do{ if(resc){ asm volatile("s_waitcnt lgkmcnt(0)":::"memory"); const float*wr_=wsf+4*(lane_now()>>5); \
      _Pragma("unroll") for(int d_=0;d_<2;++d_) _Pragma("unroll") for(int r=0;r<16;++r)o[d_][r]*=wr_[crow(r,0)]; } }while(0)
  f32x16 pA0,pA1,pB0,pB1;
  int sl_prev=0,sl_cur=0,sl_next=SLOTB;
  #define ROT() do{sl_prev=sl_cur;sl_cur=sl_next;sl_next=(sl_next==(NSLOT-1)*SLOTB)?0:sl_next+SLOTB;}while(0)
  DMA_K(2,2*SLOTB);
  WAIT_BAR(3);
  qkt(pA0,pA1,Kbase,qr,negm,r32,hi);asm volatile("s_nop 15\n\ts_nop 7":"+v"(pA0),"+v"(pA1));CMASK(pA0,pA1,0);
  START(pA0,pA1);
  _Pragma("unroll") for(int r=0;r<16;++r)pA1[r]=__builtin_amdgcn_exp2f(pA1[r]);
  WAIT_BAR(0);
  DMA_K(3,0);DMA_V(1,SLOTB);
  ROT();
  kload8(kf,kp0+sl_cur);
  WAIT_BAR(2);
  s16x4 vlo[8],vhi[8]; u32x4 pw0,pw1,pw2,pw3;
  #define PKW(P,B) cvtpk_s(P[B],P[B+1])
  #define PAF(k) __builtin_bit_cast(bf16x8,pw##k)
  #define VFR(i) (bf16x8){vlo[i][0],vlo[i][1],vlo[i][2],vlo[i][3],vhi[i][0],vhi[i][1],vhi[i][2],vhi[i][3]}
  #define PIN(x) asm volatile("":"+v"(x))
  #define MX3(a,b,c) __builtin_fmaxf(__builtin_fmaxf((a),(b)),(c))
  #define GAPA(MF,A0,A1,A2,A3,W0,W1,PW) do{ MF; sacc+=A0; sacc+=A1; sacc+=A2; sacc+=A3; PIN(sacc); W0; W1; PIN(PW); SBAR(); }while(0)
  #define EX(v) __builtin_amdgcn_exp2f(v)
  #define GAPB(MF,X,B) do{ MF; X[B]=EX(X[B]); X[B+1]=EX(X[B+1]); X[B+2]=EX(X[B+2]); X[B+3]=EX(X[B+3]); PIN(X); SBAR(); }while(0)
  #define VRD(i) do{ vlo[i]=vtr(vp_+(((i)>>2)*512+((i)&3)*2048)); vhi[i]=vtr(vp_+(((i)>>2)*512+((i)&3)*2048+1024)); }while(0)
  #define KRD(G,j) do{ if(G){ kload2(kf,kp0+sl_next,j); SBAR(); } }while(0)
  #define STEP(C0,C1,P0,P1,t,GK,GV,GL,MP,SC) do{ SBAR(); \
    const lds_cptr vp_=vp0+sl_prev; \
    VRD(0); SBAR(); float sacc=(P0[0]+P0[1]); \
    GAPA(C0=__builtin_amdgcn_mfma_f32_32x32x16_bf16(kf[0],qr[0],negm,0,0,0), P0[2],P0[3],P0[4],P0[5],     pw0[0]=PKW(P0,0), pw0[1]=PKW(P0,2), pw0); \
    VRD(4); SBAR(); GAPA(C1=__builtin_amdgcn_mfma_f32_32x32x16_bf16(kf[1],qr[0],negm,0,0,0), P0[6],P0[7],P0[8],P0[9],     pw0[2]=PKW(P0,4), pw0[3]=PKW(P0,6), pw0); \
    VRD(1); SBAR(); GAPA(C0=__builtin_amdgcn_mfma_f32_32x32x16_bf16(kf[2],qr[1],C0,0,0,0),   P0[10],P0[11],P0[12],P0[13], pw1[0]=PKW(P0,8), pw1[1]=PKW(P0,10), pw1); \
    VRD(5); SBAR(); GAPA(C1=__builtin_amdgcn_mfma_f32_32x32x16_bf16(kf[3],qr[1],C1,0,0,0),   P0[14],P0[15],P1[0],P1[1],   pw1[2]=PKW(P0,12),pw1[3]=PKW(P0,14), pw1); \
    VRD(2); SBAR(); GAPA(C0=__builtin_amdgcn_mfma_f32_32x32x16_bf16(kf[4],qr[2],C0,0,0,0),   P1[2],P1[3],P1[4],P1[5],     pw2[0]=PKW(P1,0), pw2[1]=PKW(P1,2), pw2); \
    VRD(6); SBAR(); GAPA(C1=__builtin_amdgcn_mfma_f32_32x32x16_bf16(kf[5],qr[2],C1,0,0,0),   P1[6],P1[7],P1[8],P1[9],     pw2[2]=PKW(P1,4), pw2[3]=PKW(P1,6), pw2); \
    VRD(3); SBAR(); GAPA(C0=__builtin_amdgcn_mfma_f32_32x32x16_bf16(kf[6],qr[3],C0,0,0,0),   P1[10],P1[11],P1[12],P1[13], pw3[0]=PKW(P1,8), pw3[1]=PKW(P1,10), pw3); \
    VRD(7); SBAR(); GAPA(C1=__builtin_amdgcn_mfma_f32_32x32x16_bf16(kf[7],qr[3],C1,0,0,0),   P1[14],P1[15],0.f,0.f,       pw3[2]=PKW(P1,12),pw3[3]=PKW(P1,14), pw3); \
    { const unsigned mp_=(MP); l_reg+=__uint_as_float(__float_as_uint(sacc)&mp_); pw0&=mp_; pw1&=mp_; pw2&=mp_; pw3&=mp_; } \
    if(GK){DMA_K((t)+3,sl_cur);} if(GV){DMA_V((t)+1,sl_next);} \
    CMASK(C0,C1,t); \
    { float a=MX3(C0[0],C0[1],C1[0]),b=MX3(C0[2],C0[3],C1[1]); a=MX3(a,C1[2],C1[3]); \
      _Pragma("unroll") for(int r=4;r<16;r+=4){a=MX3(a,C0[r],C0[r+1]);b=MX3(b,C0[r+2],C0[r+3]);a=MX3(a,C1[r],C1[r+1]);b=MX3(b,C1[r+2],C1[r+3]);} \
      float rm=__builtin_fmaxf(a,b); { auto rr=__builtin_amdgcn_permlane32_swap(__float_as_uint(rm),__float_as_uint(rm),false,false); rm=__builtin_fmaxf(__uint_as_float(rr[0]),__uint_as_float(rr[1])); } \
      rm=(SC)?rm:-INFINITY; \
      resc=false; \
      if(__builtin_expect(__any(rm>(float)THRL),0)){ const float dl=__builtin_fmaxf(rm,0.f); mhat+=dl; \
        _Pragma("unroll") for(int r=0;r<16;++r){C0[r]-=dl;C1[r]-=dl;} \
        _Pragma("unroll") for(int r=0;r<16;++r)negm[r]=-mhat; asm volatile("":"+v"(negm)); \
        const float f=__builtin_amdgcn_exp2f(-dl); l_reg*=f; { const int ln_=lane_now(); if(ln_<32)wsf[ln_]=f; } resc=true; } } \
    SBAR(); \
    GAPB(o[0]=__builtin_amdgcn_mfma_f32_32x32x16_bf16(PAF(0),VFR(0),o[0],0,0,0), C0,0); \
    GAPB(o[1]=__builtin_amdgcn_mfma_f32_32x32x16_bf16(PAF(0),VFR(4),o[1],0,0,0), C0,4); \
    KRD(GL,0); GAPB(o[0]=__builtin_amdgcn_mfma_f32_32x32x16_bf16(PAF(1),VFR(1),o[0],0,0,0), C0,8); \
    KRD(GL,1); GAPB(o[1]=__builtin_amdgcn_mfma_f32_32x32x16_bf16(PAF(1),VFR(5),o[1],0,0,0), C0,12); \
    KRD(GL,2); GAPB(o[0]=__builtin_amdgcn_mfma_f32_32x32x16_bf16(PAF(2),VFR(2),o[0],0,0,0), C1,0); \
    KRD(GL,3); GAPB(o[1]=__builtin_amdgcn_mfma_f32_32x32x16_bf16(PAF(2),VFR(6),o[1],0,0,0), C1,4); \
    GAPB(o[0]=__builtin_amdgcn_mfma_f32_32x32x16_bf16(PAF(3),VFR(3),o[0],0,0,0), C1,8); \
    GAPB(o[1]=__builtin_amdgcn_mfma_f32_32x32x16_bf16(PAF(3),VFR(7),o[1],0,0,0), C1,12); \
    }while(0)
  int t=1;
  #undef CMASK
  #define CMASK(P0,P1,t) do{}while(0)
  for(;t+5<NT;t+=2){
    STEP(pB0,pB1,pA0,pA1,t,true,true,true,MASKOF(t-1),SELOF(t));     WAIT_BAR(2); RESC(); ROT();
    STEP(pA0,pA1,pB0,pB1,t+1,true,true,true,MASKOF(t),SELOF(t+1));   WAIT_BAR(2); RESC(); ROT();
  }
  #undef CMASK
  #define CMASK(P0,P1,t) do{int jb_=(t)-(NT-4); if(jb_>=0)cmask(P0,P1,jb_,qrel,hi);}while(0)
  #define ENDW(tt) do{ if((tt)+3<NT){WAIT_BAR(2);} else if((tt)+2<NT){WAIT_BAR(1);} else {WAIT_BAR(0);} }while(0)
  for(;t+1<NT;t+=2){
    STEP(pB0,pB1,pA0,pA1,t,(t+3<NT),(t+1<NT),(t+1<NT),MASKOF(t-1),SELOF(t));       ENDW(t);   RESC(); ROT();
    STEP(pA0,pA1,pB0,pB1,t+1,(t+4<NT),(t+2<NT),(t+2<NT),MASKOF(t),SELOF(t+1));     ENDW(t+1); RESC(); ROT();
  }
  STEP(pB0,pB1,pA0,pA1,NT-1,false,false,false,MASKOF(NT-2),true); RESC();
  { float sacc=pB0[0]+pB0[1]; _Pragma("unroll") for(int r=2;r<16;++r)sacc+=pB0[r]; _Pragma("unroll") for(int r=0;r<16;++r)sacc+=pB1[r]; l_reg+=sacc;
    pw0=(u32x4){PKW(pB0,0),PKW(pB0,2),PKW(pB0,4),PKW(pB0,6)};pw1=(u32x4){PKW(pB0,8),PKW(pB0,10),PKW(pB0,12),PKW(pB0,14)};pw2=(u32x4){PKW(pB1,0),PKW(pB1,2),PKW(pB1,4),PKW(pB1,6)};pw3=(u32x4){PKW(pB1,8),PKW(pB1,10),PKW(pB1,12),PKW(pB1,14)};
    const int ln_=lane_now(); const int vb0=(int)(lds0+LDS_V)+((ln_>>4)&1)*32+(ln_&3)*8+(4*(ln_>>5)+((ln_&15)>>2))*64;
    SBAR(); pv(o,vb0+sl_cur,PAF(0),PAF(1),PAF(2),PAF(3)); }
  #undef PKW
  #undef PAF
  #undef VFR
  #undef PIN
  #undef MX3
  #undef GAPA
  #undef GAPB
  #undef EX
  #undef VRD
  #undef KRD
  #undef STEP
  #undef ENDW
  {auto rr=__builtin_amdgcn_permlane32_swap(__float_as_uint(l_reg),__float_as_uint(l_reg),false,false);l_reg=__uint_as_float(rr[0])+__uint_as_float(rr[1]);}
  if(hi==0)wsf[32+r32]=l_reg;asm volatile("s_waitcnt lgkmcnt(0)":::"memory");
  float rli[16];
  #pragma unroll
  for(int r=0;r<16;++r)rli[r]=__builtin_amdgcn_rcpf(wsf[32+crow(r,hi)]);
  AGAS bf16*Ow=O+(rowbase+q0+wid*QBLK)*DMP+h*D;
  { bf16*stg=(bf16*)(shm+LDS_OST)+wid*2048;
    #pragma unroll
    for(int r=0;r<16;++r){const int orow=crow(r,hi);
      #pragma unroll
      for(int d0=0;d0<2;++d0)stg[orow*64+d0*32+r32]=f2bf_s(o[d0][r]*rli[r]);}
    asm volatile("s_waitcnt lgkmcnt(0)":::"memory");
    #pragma unroll
    for(int i=0;i<4;++i){const int row=i*8+(lane>>3),ch=lane&7; const u32x4 v=*(const u32x4*)(stg+row*64+ch*8); *(AGAS u32x4*)(Ow+(long)row*DMP+ch*8)=v;
      float sq=0.f;
      #pragma unroll
      for(int e=0;e<4;++e){ const float lo=__builtin_bit_cast(float,v[e]<<16), hi2=__builtin_bit_cast(float,v[e]&0xffff0000u); sq+=lo*lo+hi2*hi2; }
      sq+=__shfl_xor(sq,1); sq+=__shfl_xor(sq,2); sq+=__shfl_xor(sq,4);
      if(ch==0) ss[(size_t)(rowbase+q0+wid*QBLK+row)*16+h]=sq; } }
  asm volatile("s_waitcnt lgkmcnt(0)\n\ts_barrier":::"memory");
  #undef DMA_K
  #undef DMA_V
  #undef CMASK
  #undef START
  #undef RESC
  #undef ROT
  #undef MASKOF
  #undef SELOF
}
constexpr int ATTN_LDS_BYTES=LDS_BYTES;
#undef SBAR
#undef WAIT_BAR
}

namespace dil_body {
using attn_body::bf16x8; using attn_body::s16x4; using attn_body::f32x16; using attn_body::u32x4; using attn_body::bf16; using attn_body::lds_cptr;
using attn_body::crow; using attn_body::glds16; using attn_body::vtr; using attn_body::cvtpk_s; using attn_body::f2bf_s;
constexpr int NGRP=33, WBUF=8192, WLDS=2*WBUF;
#define DGAS __attribute__((address_space(1)))
#define DLAS __attribute__((address_space(3)))
template<int THRL> __device__ __forceinline__ void dil_item(int b,int h,int blk,int r,int SEQL,DGAS const bf16*Q,DGAS const bf16*K,DGAS const bf16*V,DGAS bf16*O,DGAS float*ss,char*wlds,float*wsf){
  int lane_; asm volatile("v_mbcnt_lo_u32_b32 %0, -1, 0\n\tv_mbcnt_hi_u32_b32 %0, -1, %0":"=v"(lane_));
  const int lane=lane_,r32=lane&31,hi=lane>>5;
  const int T0=blk*512, tq=T0+r+16*r32; const long rowbase=(long)b*SEQL;
  DGAS const bf16*Qrow=Q+(rowbase+tq)*1024+512+h*64;
  DGAS const bf16*Kh=K+rowbase*1024+512+h*64; DGAS const bf16*Vh=V+rowbase*1024+512+h*64;
  bf16x8 qr[4];
  #pragma unroll
  for(int d0=0;d0<4;++d0)qr[d0]=*reinterpret_cast<DGAS const bf16x8*>(Qrow+d0*16+hi*8);
  asm volatile("s_waitcnt vmcnt(0)":"+v"(qr[0]),"+v"(qr[1]),"+v"(qr[2]),"+v"(qr[3])::"memory");
  const unsigned lds0=(unsigned)(uintptr_t)wlds; const lds_cptr w3=(lds_cptr)wlds;
  #define GPARAMS(gi,base,sh,W) int base,sh,W; if((gi)<5){sh=4;base=T0+r-2048+512*(gi);W=2048;} else if((gi)<13){sh=2;base=T0+(r&3)-512+128*((gi)-5);W=512;} else {sh=0;base=T0+r-128+32*((gi)-13);W=128;}
  #define CLAMPT(x) ((x)<0?0:((x)>SEQL-1?SEQL-1:(x)))
  #define ISSUE(gi,buf) do{ GPARAMS(gi,base_,sh_,W_); (void)W_; \
      const int tk_=CLAMPT(base_+((lane&31)<<sh_)); DGAS const bf16*ks_=Kh+(long)tk_*1024+(lane>>5)*8; \
      const int tv0_=CLAMPT(base_+((lane>>2)<<sh_)), tv1_=CLAMPT(base_+(((lane>>2)+16)<<sh_)); \
      DGAS const bf16*vs0_=Vh+(long)tv0_*1024+(lane&3)*8; DGAS const bf16*vs1_=Vh+(long)tv1_*1024+(lane&3)*8; \
      const unsigned kd_=(unsigned)__builtin_amdgcn_readfirstlane(lds0+(buf)*WBUF), vd_=kd_+4096; \
      glds16((const void*)(ks_),kd_); glds16((const void*)(ks_+16),kd_+1024); glds16((const void*)(ks_+32),kd_+2048); glds16((const void*)(ks_+48),kd_+3072); \
      glds16((const void*)(vs0_),vd_); glds16((const void*)(vs1_),vd_+1024); glds16((const void*)(vs0_+32),vd_+2048); glds16((const void*)(vs1_+32),vd_+3072); }while(0)
  float mhat=0.f,l_reg=0.f; f32x16 o[2]; o[0]=f32x16{}; o[1]=f32x16{}; f32x16 negm=f32x16{};
  ISSUE(0,0);
  #pragma nounroll
  for(int gi=0;gi<NGRP;++gi){
    const int buf=gi&1;
    if(gi+1<NGRP){ ISSUE(gi+1,buf^1); asm volatile("s_waitcnt vmcnt(8)":::"memory"); } else { asm volatile("s_waitcnt vmcnt(0)":::"memory"); }
    const lds_cptr kp=w3+buf*WBUF+hi*512+r32*16;
    f32x16 p;
    { const bf16x8 k0=*(DLAS const bf16x8*)(kp), k1=*(DLAS const bf16x8*)(kp+1024), k2=*(DLAS const bf16x8*)(kp+2048), k3=*(DLAS const bf16x8*)(kp+3072);
      p=__builtin_amdgcn_mfma_f32_32x32x16_bf16(k0,qr[0],negm,0,0,0); p=__builtin_amdgcn_mfma_f32_32x32x16_bf16(k1,qr[1],p,0,0,0);
      p=__builtin_amdgcn_mfma_f32_32x32x16_bf16(k2,qr[2],p,0,0,0); p=__builtin_amdgcn_mfma_f32_32x32x16_bf16(k3,qr[3],p,0,0,0); }
    { GPARAMS(gi,base,sh,W); const unsigned bound=(unsigned)(W<tq?W:tq); const int dl0=tq-base-((4*hi)<<sh);
      #pragma unroll
      for(int rr=0;rr<16;++rr){ const int dlt=dl0-(((rr&3)+8*(rr>>2))<<sh); if((unsigned)dlt>bound)p[rr]=-INFINITY; } }
    float rm=p[0];
    #pragma unroll
    for(int rr=1;rr<16;++rr)rm=__builtin_fmaxf(rm,p[rr]);
    { auto sw=__builtin_amdgcn_permlane32_swap(__float_as_uint(rm),__float_as_uint(rm),false,false); rm=__builtin_fmaxf(__uint_as_float(sw[0]),__uint_as_float(sw[1])); }
    bool resc=false;
    if(gi==0){ const float dl=(rm>-INFINITY)?rm:0.f; mhat=dl;
      #pragma unroll
      for(int rr=0;rr<16;++rr){p[rr]-=dl; negm[rr]=-mhat;} }
    else if(__any(rm>(float)THRL)){ const float dl=__builtin_fmaxf(rm,0.f); mhat+=dl;
      #pragma unroll
      for(int rr=0;rr<16;++rr){p[rr]-=dl; negm[rr]=-mhat;}
      const float f=__builtin_amdgcn_exp2f(-dl); l_reg*=f; if(hi==0)wsf[r32]=f; resc=true; }
    float sacc=0.f;
    #pragma unroll
    for(int rr=0;rr<16;++rr){p[rr]=__builtin_amdgcn_exp2f(p[rr]); sacc+=p[rr];}
    l_reg+=sacc;
    if(resc){ asm volatile("s_waitcnt lgkmcnt(0)":::"memory");
      #pragma unroll
      for(int d_=0;d_<2;++d_)
        #pragma unroll
        for(int rr=0;rr<16;++rr)o[d_][rr]*=wsf[crow(rr,hi)]; }
    u32x4 pw0,pw1;
    pw0=(u32x4){cvtpk_s(p[0],p[1]),cvtpk_s(p[2],p[3]),cvtpk_s(p[4],p[5]),cvtpk_s(p[6],p[7])};
    pw1=(u32x4){cvtpk_s(p[8],p[9]),cvtpk_s(p[10],p[11]),cvtpk_s(p[12],p[13]),cvtpk_s(p[14],p[15])};
    const lds_cptr vp=w3+buf*WBUF+4096+((lane>>4)&1)*32+(lane&3)*8+(4*hi+((lane&15)>>2))*64;
    #pragma unroll
    for(int d0=0;d0<2;++d0){
      const s16x4 a0=vtr(vp+d0*2048), a1=vtr(vp+d0*2048+512), c0=vtr(vp+d0*2048+1024), c1=vtr(vp+d0*2048+1536);
      const bf16x8 v0=(bf16x8){a0[0],a0[1],a0[2],a0[3],a1[0],a1[1],a1[2],a1[3]}, v1=(bf16x8){c0[0],c0[1],c0[2],c0[3],c1[0],c1[1],c1[2],c1[3]};
      o[d0]=__builtin_amdgcn_mfma_f32_32x32x16_bf16(__builtin_bit_cast(bf16x8,pw0),v0,o[d0],0,0,0);
      o[d0]=__builtin_amdgcn_mfma_f32_32x32x16_bf16(__builtin_bit_cast(bf16x8,pw1),v1,o[d0],0,0,0); }
    asm volatile("s_waitcnt lgkmcnt(0)":::"memory");
  }
  {auto sw=__builtin_amdgcn_permlane32_swap(__float_as_uint(l_reg),__float_as_uint(l_reg),false,false);l_reg=__uint_as_float(sw[0])+__uint_as_float(sw[1]);}
  if(hi==0)wsf[32+r32]=l_reg; asm volatile("s_waitcnt lgkmcnt(0)":::"memory");
  float rli[16];
  #pragma unroll
  for(int rr=0;rr<16;++rr)rli[rr]=__builtin_amdgcn_rcpf(wsf[32+crow(rr,hi)]);
  { bf16*stg=(bf16*)wlds;
    #pragma unroll
    for(int rr=0;rr<16;++rr){const int orow=crow(rr,hi);
      #pragma unroll
      for(int d0=0;d0<2;++d0)stg[orow*64+d0*32+r32]=f2bf_s(o[d0][rr]*rli[rr]);}
    asm volatile("s_waitcnt lgkmcnt(0)":::"memory");
    #pragma unroll
    for(int i=0;i<4;++i){const int row=i*8+(lane>>3),ch=lane&7; const u32x4 v=*(const u32x4*)(stg+row*64+ch*8);
      const long grow=rowbase+T0+r+16*row;
      *(DGAS u32x4*)(O+grow*1024+512+h*64+ch*8)=v;
      float sq=0.f;
      #pragma unroll
      for(int e=0;e<4;++e){ const float lo=__builtin_bit_cast(float,v[e]<<16), hi2=__builtin_bit_cast(float,v[e]&0xffff0000u); sq+=lo*lo+hi2*hi2; }
      sq+=__shfl_xor(sq,1); sq+=__shfl_xor(sq,2); sq+=__shfl_xor(sq,4);
      if(ch==0) ss[(size_t)grow*16+8+h]=sq; }
    asm volatile("s_waitcnt lgkmcnt(0)":::"memory"); }
  #undef GPARAMS
  #undef CLAMPT
  #undef ISSUE
}
}

namespace dil2 {
using attn_body::bf16x8; using attn_body::s16x4; using attn_body::f32x16; using attn_body::u32x4; using attn_body::bf16; using attn_body::lds_cptr;
using attn_body::crow; using attn_body::glds16; using attn_body::vtr; using attn_body::cvtpk_s; using attn_body::f2bf_s;
constexpr int GB=8192, NG=12, STG_OFF=NG*GB, WS_OFF=STG_OFF+8*4096, LDS_BYTES=WS_OFF;
#define DGAS __attribute__((address_space(1)))
#define DLAS __attribute__((address_space(3)))
__device__ __forceinline__ void dil_unit(int b,int h,int cfg,int cl,int ch,int SEQL,DGAS const bf16*Q,DGAS const bf16*K,DGAS const bf16*V,DGAS bf16*Pout,DGAS float*LSE,char*shm,float*wsf,const int wid){
  int lane_; asm volatile("v_mbcnt_lo_u32_b32 %0, -1, 0\n\tv_mbcnt_hi_u32_b32 %0, -1, %0":"=v"(lane_));
  const int lane=lane_,r32=lane&31,hi=lane>>5;
  const int sh=2*cfg, j0=256*ch; const long rowbase=(long)b*SEQL;
  const int tq=cl+((j0+32*wid+r32)<<sh);
  DGAS const bf16*Qrow=Q+(rowbase+tq)*1024+512+h*64;
  DGAS const bf16*Kh=K+rowbase*1024+512+h*64; DGAS const bf16*Vh=V+rowbase*1024+512+h*64;
  bf16x8 qr[4];
  #pragma unroll
  for(int d0=0;d0<4;++d0)qr[d0]=*reinterpret_cast<DGAS const bf16x8*>(Qrow+d0*16+hi*8);
  const unsigned lds0=(unsigned)(uintptr_t)shm; const lds_cptr s3=(lds_cptr)shm;
  const int gfirst=(ch==0)?4:0;
  #pragma unroll
  for(int k=0;k<12;++k){ const int n=wid*12+k, g=n>>3, c=n&7;
    if(g>=gfirst){
      const int isv=c>>2, cc=c&3;
      const int row=isv?(16*(cc&1)+(lane>>2)):(lane&31);
      const int tk=cl+((j0-128+32*g+row)<<sh);
      DGAS const bf16*src=(isv?Vh:Kh)+(long)tk*1024+(isv?((cc>>1)*32+(lane&3)*8):((2*cc+(lane>>5))*8));
      glds16((const void*)src,(unsigned)__builtin_amdgcn_readfirstlane(lds0+g*GB+c*1024)); } }
  asm volatile("s_waitcnt vmcnt(0)":"+v"(qr[0]),"+v"(qr[1]),"+v"(qr[2]),"+v"(qr[3])::"memory");
  asm volatile("s_barrier":::"memory");
  f32x16 p[5];
  #pragma unroll
  for(int gg=0;gg<5;++gg){
    if(wid+gg>=gfirst){
      const lds_cptr kp=s3+(wid+gg)*GB+hi*512+r32*16;
      const bf16x8 k0=*(DLAS const bf16x8*)(kp), k1=*(DLAS const bf16x8*)(kp+1024), k2=*(DLAS const bf16x8*)(kp+2048), k3=*(DLAS const bf16x8*)(kp+3072);
      f32x16 a=f32x16{};
      a=__builtin_amdgcn_mfma_f32_32x32x16_bf16(k0,qr[0],a,0,0,0); a=__builtin_amdgcn_mfma_f32_32x32x16_bf16(k1,qr[1],a,0,0,0);
      a=__builtin_amdgcn_mfma_f32_32x32x16_bf16(k2,qr[2],a,0,0,0); a=__builtin_amdgcn_mfma_f32_32x32x16_bf16(k3,qr[3],a,0,0,0);
      p[gg]=a;
    } else {
      #pragma unroll
      for(int rr=0;rr<16;++rr)p[gg][rr]=-INFINITY; } }
  #pragma unroll
  for(int rr=0;rr<16;++rr){ const int kk=crow(rr,hi); if(kk<r32)p[0][rr]=-INFINITY; if(kk>r32)p[4][rr]=-INFINITY; }
  float rm=p[0][0];
  #pragma unroll
  for(int gg=0;gg<5;++gg)
    #pragma unroll
    for(int rr=0;rr<16;++rr)rm=__builtin_fmaxf(rm,p[gg][rr]);
  { auto sw=__builtin_amdgcn_permlane32_swap(__float_as_uint(rm),__float_as_uint(rm),false,false); rm=__builtin_fmaxf(__uint_as_float(sw[0]),__uint_as_float(sw[1])); }
  float l_reg=0.f;
  #pragma unroll
  for(int gg=0;gg<5;++gg)
    #pragma unroll
    for(int rr=0;rr<16;++rr){p[gg][rr]=__builtin_amdgcn_exp2f(p[gg][rr]-rm); l_reg+=p[gg][rr];}
  { auto sw=__builtin_amdgcn_permlane32_swap(__float_as_uint(l_reg),__float_as_uint(l_reg),false,false); l_reg=__uint_as_float(sw[0])+__uint_as_float(sw[1]); }
  f32x16 o[2]; o[0]=f32x16{}; o[1]=f32x16{};
  #pragma unroll
  for(int gg=0;gg<5;++gg){
    if(wid+gg>=gfirst){
      u32x4 pw0,pw1;
      pw0=(u32x4){cvtpk_s(p[gg][0],p[gg][1]),cvtpk_s(p[gg][2],p[gg][3]),cvtpk_s(p[gg][4],p[gg][5]),cvtpk_s(p[gg][6],p[gg][7])};
      pw1=(u32x4){cvtpk_s(p[gg][8],p[gg][9]),cvtpk_s(p[gg][10],p[gg][11]),cvtpk_s(p[gg][12],p[gg][13]),cvtpk_s(p[gg][14],p[gg][15])};
      const lds_cptr vp=s3+(wid+gg)*GB+4096+((lane>>4)&1)*32+(lane&3)*8+(4*hi+((lane&15)>>2))*64;
      #pragma unroll
      for(int d0=0;d0<2;++d0){
        const s16x4 a0=vtr(vp+d0*2048), a1=vtr(vp+d0*2048+512), c0=vtr(vp+d0*2048+1024), c1=vtr(vp+d0*2048+1536);
        const bf16x8 v0=(bf16x8){a0[0],a0[1],a0[2],a0[3],a1[0],a1[1],a1[2],a1[3]}, v1=(bf16x8){c0[0],c0[1],c0[2],c0[3],c1[0],c1[1],c1[2],c1[3]};
        o[d0]=__builtin_amdgcn_mfma_f32_32x32x16_bf16(__builtin_bit_cast(bf16x8,pw0),v0,o[d0],0,0,0);
        o[d0]=__builtin_amdgcn_mfma_f32_32x32x16_bf16(__builtin_bit_cast(bf16x8,pw1),v1,o[d0],0,0,0); } } }
  if(hi==0){ wsf[r32]=l_reg; LSE[(size_t)(rowbase+tq)*8+h]=rm+__builtin_amdgcn_logf(l_reg); }
  asm volatile("s_waitcnt lgkmcnt(0)":::"memory");
  float rli[16];
  #pragma unroll
  for(int rr=0;rr<16;++rr)rli[rr]=__builtin_amdgcn_rcpf(wsf[crow(rr,hi)]);
  { bf16*stg=(bf16*)(shm+STG_OFF)+wid*2048;
    #pragma unroll
    for(int rr=0;rr<16;++rr){const int orow=crow(rr,hi);
      #pragma unroll
      for(int d0=0;d0<2;++d0)stg[orow*64+d0*32+r32]=f2bf_s(o[d0][rr]*rli[rr]);}
    asm volatile("s_waitcnt lgkmcnt(0)":::"memory");
    #pragma unroll
    for(int i=0;i<4;++i){const int row=i*8+(lane>>3),c8=lane&7; const u32x4 v=*(const u32x4*)(stg+row*64+c8*8);
      const long grow=rowbase+cl+((long)(j0+32*wid+row)<<sh);
      *(DGAS u32x4*)(Pout+grow*512+h*64+c8*8)=v; } }
  asm volatile("s_waitcnt lgkmcnt(0)\n\ts_barrier":::"memory");
}
__device__ __forceinline__ void dil_combine_row(long row,int lane,DGAS const bf16*Pout,DGAS const float*LSE,size_t pstride,size_t lstride,DGAS bf16*O,DGAS float*ss){
  const int head=lane>>3;
  const float l0=LSE[(size_t)row*8+head], l1=LSE[lstride+(size_t)row*8+head], l2=LSE[2*lstride+(size_t)row*8+head];
  const float mx=__builtin_fmaxf(__builtin_fmaxf(l0,l1),l2);
  float w0=__builtin_amdgcn_exp2f(l0-mx), w1=__builtin_amdgcn_exp2f(l1-mx), w2=__builtin_amdgcn_exp2f(l2-mx); const float iw=1.0f/(w0+w1+w2); w0*=iw; w1*=iw; w2*=iw;
  const u32x4 a=*(DGAS const u32x4*)(Pout+(size_t)row*512+lane*8), c=*(DGAS const u32x4*)(Pout+pstride+(size_t)row*512+lane*8), e=*(DGAS const u32x4*)(Pout+2*pstride+(size_t)row*512+lane*8);
  u32x4 outv; float sq=0.f;
  #pragma unroll
  for(int i=0;i<4;++i){
    const float lo=w0*__builtin_bit_cast(float,a[i]<<16)+w1*__builtin_bit_cast(float,c[i]<<16)+w2*__builtin_bit_cast(float,e[i]<<16);
    const float hi2=w0*__builtin_bit_cast(float,a[i]&0xffff0000u)+w1*__builtin_bit_cast(float,c[i]&0xffff0000u)+w2*__builtin_bit_cast(float,e[i]&0xffff0000u);
    const unsigned pk=cvtpk_s(lo,hi2); outv[i]=pk;
    const float rl=__builtin_bit_cast(float,pk<<16), rh=__builtin_bit_cast(float,pk&0xffff0000u); sq+=rl*rl+rh*rh; }
  *(DGAS u32x4*)(O+(size_t)row*1024+512+lane*8)=outv;
  sq+=__shfl_xor(sq,1); sq+=__shfl_xor(sq,2); sq+=__shfl_xor(sq,4);
  if((lane&7)==0) ss[(size_t)row*16+8+head]=sq;
}
}

namespace dil3 {
using attn_body::bf16x8; using attn_body::s16x4; using attn_body::f32x16; using attn_body::u32x4; using attn_body::bf16; using attn_body::lds_cptr;
using attn_body::crow; using attn_body::glds16; using attn_body::vtr; using attn_body::cvtpk_s; using attn_body::f2bf_s;
constexpr int KREG=0, VREG=49152, QREG=98304, RING_END=131072;
#define DGAS __attribute__((address_space(1)))
#define DLAS __attribute__((address_space(3)))
struct UnitP { int b,h,cfg,cl,ch; };
__device__ __forceinline__ UnitP unit_of(int i,int G,int vcu){ int bh,u; if(G==256){bh=vcu>>3;u=(vcu&7)+8*i;}else{const int it=vcu+i*G;bh=it/48;u=it%48;}
  UnitP p; p.b=bh>>3; p.h=bh&7; p.cfg=u>>4; p.cl=(p.cfg==0)?0:(p.cfg==1?((u-16)>>2):(u-32)); p.ch=(p.cfg==0)?u:(p.cfg==1?((u-16)&3):0); return p; }
__device__ __forceinline__ void dil_phase(int hotmask,int nun,int G,int vcu,int SEQL,DGAS const bf16*Q,DGAS const bf16*K,DGAS const bf16*V,DGAS bf16*Pout,size_t pstride,DGAS float*LSE,size_t lstride,char*shm,char*ostg,float*wsf,const int wid){
  if(nun<=0)return;
  int lane_; asm volatile("v_mbcnt_lo_u32_b32 %0, -1, 0\n\tv_mbcnt_hi_u32_b32 %0, -1, %0":"=v"(lane_));
  const int lane=lane_,r32=lane&31,hi=lane>>5;
  const unsigned lds0=(unsigned)(uintptr_t)shm; const lds_cptr s3=(lds_cptr)shm;
  #define CLAMPJ(j) ((j)<0?0:(j))
  #define ISSUE_K(P) do{ const int sh_=2*(P).cfg, j0_=256*(P).ch; DGAS const bf16*Kh_=K+((long)(P).b*SEQL)*1024+512+(P).h*64; \
      _Pragma("unroll") for(int k_=0;k_<6;++k_){ const int n_=wid*6+k_, g_=n_>>2, c_=n_&3; \
        const int tk_=((P).cl+(CLAMPJ(j0_-128+32*g_+(lane&31))<<sh_))&hotmask; \
        glds16((const void*)(Kh_+(long)tk_*1024+(2*c_+(lane>>5))*8),(unsigned)__builtin_amdgcn_readfirstlane(lds0+KREG+g_*4096+c_*1024)); } }while(0)
  #define ISSUE_V(P) do{ const int sh_=2*(P).cfg, j0_=256*(P).ch; DGAS const bf16*Vh_=V+((long)(P).b*SEQL)*1024+512+(P).h*64; \
      _Pragma("unroll") for(int k_=0;k_<6;++k_){ const int n_=wid*6+k_, g_=n_>>2, c_=n_&3; \
        const int tk_=((P).cl+(CLAMPJ(j0_-128+32*g_+16*(c_&1)+(lane>>2))<<sh_))&hotmask; \
        glds16((const void*)(Vh_+(long)tk_*1024+(c_>>1)*32+(lane&3)*8),(unsigned)__builtin_amdgcn_readfirstlane(lds0+VREG+g_*4096+c_*1024)); } }while(0)
  #define ISSUE_Q(P) do{ const int sh_=2*(P).cfg, j0_=256*(P).ch; DGAS const bf16*Qh_=Q+((long)(P).b*SEQL)*1024+512+(P).h*64; \
      const int tq_=(P).cl+((j0_+32*wid+(lane&31))<<sh_); \
      _Pragma("unroll") for(int c_=0;c_<4;++c_) glds16((const void*)(Qh_+(long)tq_*1024+(2*c_+(lane>>5))*8),(unsigned)__builtin_amdgcn_readfirstlane(lds0+QREG+wid*4096+c_*1024)); }while(0)
  UnitP cur=unit_of(0,G,vcu);
  ISSUE_K(cur); ISSUE_Q(cur);
  #pragma nounroll
  for(int ui=0;ui<nun;++ui){
    const bool has_next=(ui+1<nun); const UnitP nxt=has_next?unit_of(ui+1,G,vcu):cur;
    const int sh=2*cur.cfg, j0=256*cur.ch; const long rowbase=(long)cur.b*SEQL; const int gfirst=(cur.ch==0)?4:0;
    asm volatile("s_waitcnt vmcnt(0) lgkmcnt(0)\n\ts_barrier":::"memory");
    ISSUE_V(cur);
    bf16x8 qr[4];
    { const lds_cptr qp=s3+QREG+wid*4096+hi*512+r32*16;
      qr[0]=*(DLAS const bf16x8*)(qp); qr[1]=*(DLAS const bf16x8*)(qp+1024); qr[2]=*(DLAS const bf16x8*)(qp+2048); qr[3]=*(DLAS const bf16x8*)(qp+3072); }
    f32x16 p[5];
    #pragma unroll
    for(int gg=0;gg<5;++gg){
      const lds_cptr kp=s3+KREG+(wid+gg)*4096+hi*512+r32*16;
      const bf16x8 k0=*(DLAS const bf16x8*)(kp), k1=*(DLAS const bf16x8*)(kp+1024), k2=*(DLAS const bf16x8*)(kp+2048), k3=*(DLAS const bf16x8*)(kp+3072);
      f32x16 a=f32x16{};
      a=__builtin_amdgcn_mfma_f32_32x32x16_bf16(k0,qr[0],a,0,0,0); a=__builtin_amdgcn_mfma_f32_32x32x16_bf16(k1,qr[1],a,0,0,0);
      a=__builtin_amdgcn_mfma_f32_32x32x16_bf16(k2,qr[2],a,0,0,0); a=__builtin_amdgcn_mfma_f32_32x32x16_bf16(k3,qr[3],a,0,0,0);
      p[gg]=a; }
    asm volatile("s_waitcnt lgkmcnt(0)\n\ts_barrier":::"memory");
    if(has_next){ ISSUE_K(nxt); ISSUE_Q(nxt); }
    #pragma unroll
    for(int gg=0;gg<4;++gg){ if(wid+gg<gfirst){
      #pragma unroll
      for(int rr=0;rr<16;++rr)p[gg][rr]=-INFINITY; } }
    #pragma unroll
    for(int rr=0;rr<16;++rr){ const int kk=crow(rr,hi); if(kk<r32)p[0][rr]=-INFINITY; if(kk>r32)p[4][rr]=-INFINITY; }
    float rm=p[0][0];
    #pragma unroll
    for(int gg=0;gg<5;++gg)
      #pragma unroll
      for(int rr=0;rr<16;++rr)rm=__builtin_fmaxf(rm,p[gg][rr]);
    { auto sw=__builtin_amdgcn_permlane32_swap(__float_as_uint(rm),__float_as_uint(rm),false,false); rm=__builtin_fmaxf(__uint_as_float(sw[0]),__uint_as_float(sw[1])); }
    float l_reg=0.f;
    #pragma unroll
    for(int gg=0;gg<5;++gg)
      #pragma unroll
      for(int rr=0;rr<16;++rr){p[gg][rr]=__builtin_amdgcn_exp2f(p[gg][rr]-rm); l_reg+=p[gg][rr];}
    { auto sw=__builtin_amdgcn_permlane32_swap(__float_as_uint(l_reg),__float_as_uint(l_reg),false,false); l_reg=__uint_as_float(sw[0])+__uint_as_float(sw[1]); }
    if(has_next) asm volatile("s_waitcnt vmcnt(10)\n\ts_barrier":::"memory"); else asm volatile("s_waitcnt vmcnt(0)\n\ts_barrier":::"memory");
    f32x16 o[2]; o[0]=f32x16{}; o[1]=f32x16{};
    #pragma unroll
    for(int gg=0;gg<5;++gg){
      u32x4 pw0,pw1;
      pw0=(u32x4){cvtpk_s(p[gg][0],p[gg][1]),cvtpk_s(p[gg][2],p[gg][3]),cvtpk_s(p[gg][4],p[gg][5]),cvtpk_s(p[gg][6],p[gg][7])};
      pw1=(u32x4){cvtpk_s(p[gg][8],p[gg][9]),cvtpk_s(p[gg][10],p[gg][11]),cvtpk_s(p[gg][12],p[gg][13]),cvtpk_s(p[gg][14],p[gg][15])};
      const lds_cptr vp=s3+VREG+(wid+gg)*4096+((lane>>4)&1)*32+(lane&3)*8+(4*hi+((lane&15)>>2))*64;
      #pragma unroll
      for(int d0=0;d0<2;++d0){
        const s16x4 a0=vtr(vp+d0*2048), a1=vtr(vp+d0*2048+512), c0=vtr(vp+d0*2048+1024), c1=vtr(vp+d0*2048+1536);
        const bf16x8 v0=(bf16x8){a0[0],a0[1],a0[2],a0[3],a1[0],a1[1],a1[2],a1[3]}, v1=(bf16x8){c0[0],c0[1],c0[2],c0[3],c1[0],c1[1],c1[2],c1[3]};
        o[d0]=__builtin_amdgcn_mfma_f32_32x32x16_bf16(__builtin_bit_cast(bf16x8,pw0),v0,o[d0],0,0,0);
        o[d0]=__builtin_amdgcn_mfma_f32_32x32x16_bf16(__builtin_bit_cast(bf16x8,pw1),v1,o[d0],0,0,0); } }
    const int tq=cur.cl+((j0+32*wid+r32)<<sh);
    DGAS bf16*Pc=Pout+(size_t)cur.cfg*pstride; DGAS float*Lc=LSE+(size_t)cur.cfg*lstride;
    if(hi==0){ wsf[r32]=l_reg; Lc[(size_t)(rowbase+tq)*8+cur.h]=rm+__builtin_amdgcn_logf(l_reg); }
    asm volatile("s_waitcnt lgkmcnt(0)":::"memory");
    float rli[16];
    #pragma unroll
    for(int rr=0;rr<16;++rr)rli[rr]=__builtin_amdgcn_rcpf(wsf[crow(rr,hi)]);
    bf16*stg=(bf16*)ostg+wid*1024;
    #pragma unroll
    for(int ps=0;ps<2;++ps){
      #pragma unroll
      for(int r8=0;r8<8;++r8){ const int rr=8*ps+r8; const int orow=crow(r8,hi);
        #pragma unroll
        for(int d0=0;d0<2;++d0)stg[orow*64+d0*32+r32]=f2bf_s(o[d0][rr]*rli[rr]);}
      asm volatile("s_waitcnt lgkmcnt(0)":::"memory");
      #pragma unroll
      for(int i=0;i<2;++i){const int row=i*8+(lane>>3),c8=lane&7; const u32x4 v=*(const u32x4*)(stg+row*64+c8*8);
        const long grow=rowbase+cur.cl+((long)(j0+32*wid+16*ps+row)<<sh);
        *(DGAS u32x4*)(Pc+grow*512+cur.h*64+c8*8)=v; }
      asm volatile("s_waitcnt lgkmcnt(0)":::"memory"); }
    cur=nxt;
  }
  asm volatile("s_waitcnt vmcnt(0) lgkmcnt(0)\n\ts_barrier":::"memory");
  #undef CLAMPJ
  #undef ISSUE_K
  #undef ISSUE_V
  #undef ISSUE_Q
}
}

constexpr int NWAVES = 8;
constexpr size_t MiB = 1u << 20;
constexpr size_t WS_CTL = 0, CTL_ZERO_BYTES = 64 * 1024;
constexpr size_t WS_CS = 1 * MiB;
constexpr size_t WS_STA = 2 * MiB, WS_STB = 3 * MiB;
constexpr size_t WS_SS = 4 * MiB;
constexpr size_t WS_KM = 5 * MiB;
constexpr size_t WS_W = 8 * MiB, W_BUF = 24 * MiB;
constexpr size_t W_QKV = 0, W_O = 6 * MiB, W_UP = 8 * MiB, W_DN = 16 * MiB;
constexpr size_t WS_XB = 56 * MiB;
constexpr size_t WS_QO = 88 * MiB, WS_KB = 120 * MiB, WS_VB = 152 * MiB;
constexpr size_t WS_H = 88 * MiB;
constexpr size_t WS_PD = 184 * MiB, PD_STRIDE = (size_t)M * 512;
constexpr size_t WS_LSE = 232 * MiB, LSE_STRIDE = (size_t)M * 8;
constexpr size_t WS_END = 234 * MiB;
constexpr int CW_BAR = 1024;

constexpr int RING_BYTES = 131072, LDSCTL_OFF = RING_BYTES, MISC_OFF = LDSCTL_OFF + 320, LDS_BYTES = 155648;

#define GAS __attribute__((address_space(1)))
#define LAS __attribute__((address_space(3)))
typedef unsigned short bf16;
typedef unsigned v4u __attribute__((ext_vector_type(4)));
typedef unsigned v2u __attribute__((ext_vector_type(2)));
typedef float f32x4 __attribute__((ext_vector_type(4)));
typedef GAS unsigned gu32;
#define LDS_WAIT() asm volatile("s_waitcnt lgkmcnt(0)" ::: "memory")
__device__ __forceinline__ unsigned f2bf(float f) { unsigned u = __builtin_bit_cast(unsigned, f); return (u + 0x7fffu + ((u >> 16) & 1u)) >> 16; }
__device__ __forceinline__ unsigned pk2(float lo, float hi) { return f2bf(lo) | (f2bf(hi) << 16); }
__device__ __forceinline__ float bf2f(unsigned h) { return __builtin_bit_cast(float, h << 16); }
__device__ __forceinline__ float wave_sum(float v) {
#pragma unroll
    for (int o = 1; o < 64; o <<= 1) v += __shfl_xor(v, o);
    return v;
}
__device__ __forceinline__ float wave_max(float v) {
#pragma unroll
    for (int o = 1; o < 64; o <<= 1) v = fmaxf(v, __shfl_xor(v, o));
    return v;
}

#define XB_TMO      128
#define XB_XCNT(j)  (256  + 64 * (j))
#define XB_XSUB(j)  (1280 + 64 * (j))
#define XB_XGEN(j)  (2304 + 64 * (j))
#define XB_TOP      3328
#define XB_TOPGEN   3392
#define XCD_BAR_WORDS 3456
#define XB_SPIN_CAP (1u << 18)
__device__ __forceinline__ unsigned xb_ld(unsigned* p)              { return __hip_atomic_load(p, __ATOMIC_RELAXED, __HIP_MEMORY_SCOPE_AGENT); }
__device__ __forceinline__ unsigned xb_add(unsigned* p, unsigned v) { return __hip_atomic_fetch_add(p, v, __ATOMIC_RELAXED, __HIP_MEMORY_SCOPE_AGENT); }
__device__ __forceinline__ unsigned xb_xcc_id() { return (unsigned)__builtin_amdgcn_s_getreg((3 << 11) | 20) & 0xFu; }
#define XB_SPIN(cond, bar) do { unsigned _sp = 0; while (cond) { __builtin_amdgcn_s_sleep(1); \
    if ((++_sp & 255u) == 0u) { if (xb_ld(&(bar)[XB_TMO])) break; if (_sp > XB_SPIN_CAP) { atomicAdd(&(bar)[XB_TMO], 1u); break; } } } } while (0)
struct XcdBarrier { unsigned* bar; unsigned x; volatile LAS unsigned* st; };
__device__ __forceinline__ XcdBarrier xcd_barrier_post(unsigned* bar, volatile LAS unsigned* st) {
    XcdBarrier b; b.bar = bar; b.x = xb_xcc_id(); b.st = st;
    if (threadIdx.x == 0) (void)xb_add(&bar[XB_XCNT(b.x)], 1u);
    return b;
}
__device__ __forceinline__ void xcd_barrier_complete(unsigned* bar, unsigned x, unsigned& nloc, unsigned& nx) {
    const unsigned G = gridDim.x * gridDim.y * gridDim.z;
    unsigned sum, cnt, mine, sp = 0u;
    for (;;) {
        sum = 0u; cnt = 0u; mine = 0u;
#pragma unroll
        for (unsigned j = 0; j < 16; ++j) { const unsigned c = xb_ld(&bar[XB_XCNT(j)]); sum += c; cnt += (c > 0u) ? 1u : 0u; mine = (j == x) ? c : mine; }
        if (sum == G) break;
        __builtin_amdgcn_s_sleep(1);
        if ((++sp & 255u) == 0u) { if (xb_ld(&bar[XB_TMO])) break; if (sp > XB_SPIN_CAP) { atomicAdd(&bar[XB_TMO], 1u); break; } }
    }
    nloc = mine > 0u ? mine : 1u; nx = cnt > 0u ? cnt : 1u;
}
__device__ __forceinline__ void xcd_barrier(const XcdBarrier& b) {
    asm volatile("s_waitcnt vmcnt(0)" ::: "memory");
    __syncthreads();
    if (threadIdx.x == 0) {
        unsigned* bar = b.bar;
        __builtin_amdgcn_s_waitcnt(0);
        unsigned nloc = b.st[0], nx = b.st[1];
        if (nloc == 0u) { xcd_barrier_complete(bar, b.x, nloc, nx); b.st[0] = nloc; b.st[1] = nx; }
        const unsigned old = xb_add(&bar[XB_XSUB(b.x)], 1u);
        const unsigned gen = old / nloc;
        if (old + 1u == (gen + 1u) * nloc) {
            __builtin_amdgcn_fence(__ATOMIC_RELEASE, "agent");
            asm volatile("s_waitcnt vmcnt(0)" ::: "memory");
            const unsigned og = xb_add(&bar[XB_TOP], 1u);
            const unsigned tg = og / nx;
            if (og + 1u == (tg + 1u) * nx) xb_add(&bar[XB_TOPGEN], 1u);
            else XB_SPIN(xb_ld(&bar[XB_TOPGEN]) == tg, bar);
            __builtin_amdgcn_fence(__ATOMIC_ACQUIRE, "agent");
            xb_add(&bar[XB_XGEN(b.x)], 1u);
            asm volatile("s_waitcnt vmcnt(0)" ::: "memory");
        } else {
            XB_SPIN(xb_ld(&bar[XB_XGEN(b.x)]) == gen, bar);
            __builtin_amdgcn_fence(__ATOMIC_ACQUIRE, "agent");
            asm volatile("s_waitcnt vmcnt(0)" ::: "memory");
        }
    }
    __syncthreads();
}

__device__ __forceinline__ void transpose_item(GAS const float* W, int K, int N, GAS const float* gA, GAS const float* gB, int ksplit, GAS bf16* WT, int k0, int nsrc0, int ndst0, LAS float* scr, int lane) {
    float v[32];
    GAS const float* src = W + (size_t)(k0 + (lane >> 5)) * N + nsrc0 + (lane & 31);
#pragma unroll
    for (int i = 0; i < 32; ++i) v[i] = src[(size_t)(2 * i) * N];
    float g0 = 1.0f, g1 = 1.0f;
    if (gA) { const int k = k0 + lane; g0 = (k < ksplit) ? gA[k] : gB[k - ksplit]; } (void)g1;
#pragma unroll
    for (int i = 0; i < 32; ++i) { const int kk = 2 * i + (lane >> 5); const float g = __shfl(g0, kk); scr[kk * 33 + (lane & 31)] = v[i] * g; }
    LDS_WAIT(); asm volatile("" ::: "memory");
    const int c = lane & 7;
#pragma unroll
    for (int j = 0; j < 4; ++j) { const int n = (lane >> 3) + 8 * j; const LAS float* s = scr + (8 * c) * 33 + n;
        v4u o; o.x = pk2(s[0 * 33], s[1 * 33]); o.y = pk2(s[2 * 33], s[3 * 33]); o.z = pk2(s[4 * 33], s[5 * 33]); o.w = pk2(s[6 * 33], s[7 * 33]);
        *(GAS v4u*)(WT + (size_t)(ndst0 + n) * K + k0 + 8 * c) = o; }
    LDS_WAIT(); asm volatile("" ::: "memory");
}
__device__ __forceinline__ int qkv_src_col(int c) {
    const int pn = c >> 8, p = c & 255, tl = 64 * ((p >> 5) & 3) + 32 * (p >> 7), j = 256 * (pn & 3) + tl, a = pn >> 2;
    return (j < 512) ? (a * 512 + j) : (1536 + a * 512 + (j - 512));
}
struct LayerW { GAS const float *attn_norm, *w_in, *moba_norm, *dil_norm, *w_out, *mlp_norm, *w_up, *w_down; };
__device__ __forceinline__ void convert_layer(const LayerW& L, GAS unsigned char* wb, LAS float* scr, int gw, int NGW, int lane) {
    constexpr int I_QKV = (DM / 64) * (NQKV / 32), I_O = (DM / 64) * (DM / 32), I_UP = (DM / 64) * (DFF / 32), I_DN = (DFF / 64) * (DM / 32);
    for (int it = gw; it < I_QKV + I_O + I_UP + I_DN; it += NGW) {
        int r = it; GAS const float* W; GAS const float* gA; GAS const float* gB; int K, N, ksplit, nb, kb, nsrc; GAS bf16* WT;
        if (r < I_QKV) { nb = r % (NQKV / 32); kb = r / (NQKV / 32); W = L.w_in; K = DM; N = NQKV; gA = L.attn_norm; gB = L.attn_norm; ksplit = DM; WT = (GAS bf16*)(wb + W_QKV); nsrc = qkv_src_col(32 * nb); }
        else if (r < I_QKV + I_O) { r -= I_QKV; nb = r % (DM / 32); kb = r / (DM / 32); W = L.w_out; K = DM; N = DM; gA = L.moba_norm; gB = L.dil_norm; ksplit = 512; WT = (GAS bf16*)(wb + W_O); nsrc = 32 * nb; }
        else if (r < I_QKV + I_O + I_UP) { r -= I_QKV + I_O; nb = r % (DFF / 32); kb = r / (DFF / 32); W = L.w_up; K = DM; N = DFF; gA = L.mlp_norm; gB = L.mlp_norm; ksplit = DM; WT = (GAS bf16*)(wb + W_UP); nsrc = 32 * nb; }
        else { r -= I_QKV + I_O + I_UP; nb = r % (DM / 32); kb = r / (DM / 32); W = L.w_down; K = DFF; N = DM; gA = nullptr; gB = nullptr; ksplit = 0; WT = (GAS bf16*)(wb + W_DN); nsrc = 32 * nb; }
        transpose_item(W, K, N, gA, gB, ksplit, WT, 64 * kb, nsrc, 32 * nb, scr, lane);
    }
}

#define KEY_UPDATE(krow, vrow, valid)                                                                                   \
    do {                                                                                                                \
        if (valid) {                                                                                                    \
            float s = 0.f;                                                                                              \
            _Pragma("unroll") for (int c = 0; c < 8; ++c) {                                                             \
                const v4u kk = ((GAS const v4u*)(krow))[c];                                                             \
                s += qv[8 * c + 0] * bf2f(kk.x & 0xffffu) + qv[8 * c + 1] * bf2f(kk.x >> 16) + qv[8 * c + 2] * bf2f(kk.y & 0xffffu) + qv[8 * c + 3] * bf2f(kk.y >> 16) \
                   + qv[8 * c + 4] * bf2f(kk.z & 0xffffu) + qv[8 * c + 5] * bf2f(kk.z >> 16) + qv[8 * c + 6] * bf2f(kk.w & 0xffffu) + qv[8 * c + 7] * bf2f(kk.w >> 16); \
            }                                                                                                           \
            if (s > mrun) { const float f = exp2f(mrun - s); lrun *= f; _Pragma("unroll") for (int d = 0; d < 64; ++d) ov[d] *= f; mrun = s; } \
            const float p = exp2f(s - mrun); lrun += p;                                                                 \
            _Pragma("unroll") for (int c = 0; c < 8; ++c) {                                                             \
                const v4u vv = ((GAS const v4u*)(vrow))[c];                                                             \
                ov[8 * c + 0] += p * bf2f(vv.x & 0xffffu); ov[8 * c + 1] += p * bf2f(vv.x >> 16); ov[8 * c + 2] += p * bf2f(vv.y & 0xffffu); ov[8 * c + 3] += p * bf2f(vv.y >> 16); \
                ov[8 * c + 4] += p * bf2f(vv.z & 0xffffu); ov[8 * c + 5] += p * bf2f(vv.z >> 16); ov[8 * c + 6] += p * bf2f(vv.w & 0xffffu); ov[8 * c + 7] += p * bf2f(vv.w >> 16); \
            }                                                                                                           \
        }                                                                                                               \
    } while (0)
#define WAVE_FINISH(orow, ssptr)                                                                                        \
    do {                                                                                                                \
        const float mall = wave_max(mrun);                                                                              \
        const float f = (mrun > -1e37f) ? exp2f(mrun - mall) : 0.f;                                                     \
        const float ltot = wave_sum(lrun * f); const float il = 1.0f / ltot;                                            \
        float mine = 0.f, sq = 0.f;                                                                                     \
        _Pragma("unroll") for (int d = 0; d < 64; ++d) { const float od = wave_sum(ov[d] * f) * il; sq += od * od; if (lane == d) mine = od; } \
        (orow)[lane] = (bf16)f2bf(mine);                                                                                \
        if (lane == 0) *(ssptr) = sq;                                                                                   \
    } while (0)
#define LOAD_Q(qptr)                                                                                                    \
    float qv[64];                                                                                                       \
    { GAS const v4u* qp = (GAS const v4u*)(qptr);                                                                           \
      _Pragma("unroll") for (int c = 0; c < 8; ++c) { const v4u u = qp[c];                                            \
        qv[8 * c + 0] = bf2f(u.x & 0xffffu); qv[8 * c + 1] = bf2f(u.x >> 16); qv[8 * c + 2] = bf2f(u.y & 0xffffu); qv[8 * c + 3] = bf2f(u.y >> 16); \
        qv[8 * c + 4] = bf2f(u.z & 0xffffu); qv[8 * c + 5] = bf2f(u.z >> 16); qv[8 * c + 6] = bf2f(u.w & 0xffffu); qv[8 * c + 7] = bf2f(u.w >> 16); } }

__device__ __forceinline__ void moba_naive_one(int w, int lane, GAS bf16* QO, GAS const bf16* KB, GAS const bf16* VB, GAS const float* kmean, GAS float* ss) {
    const int t = w & (SEQ - 1), h = (w >> 12) & 7, b = w >> 15, m = b * SEQ + t, qb = t >> 8;
    LOAD_Q(QO + (size_t)m * DM + h * 64);
    float gj;
    { const int j = lane & 15; GAS const f32x4* kmp = (GAS const f32x4*)(kmean + (size_t)((b * 8 + h) * 16 + j) * 64);
      float s = 0.f;
#pragma unroll
      for (int c = 0; c < 16; ++c) { const f32x4 k4 = kmp[c]; s += qv[4 * c] * k4.x + qv[4 * c + 1] * k4.y + qv[4 * c + 2] * k4.z + qv[4 * c + 3] * k4.w; }
      gj = (j < qb) ? s : -1e30f; }
    unsigned sel = 0u;
#pragma unroll
    for (int r = 0; r < 3; ++r) {
        float best = -INFINITY; int bi = 0;
#pragma unroll
        for (int jj = 0; jj < 16; ++jj) { const float v = __shfl(gj, jj); const bool ok = !((sel >> jj) & 1u); if (ok && v > best) { best = v; bi = jj; } }
        sel |= 1u << bi;
    }
    sel &= (1u << qb) - 1u; sel |= 1u << qb;
    float ov[64]; float mrun = -INFINITY, lrun = 0.f;
#pragma unroll
    for (int d = 0; d < 64; ++d) ov[d] = 0.f;
    GAS const bf16* kbase = KB + (size_t)(b * SEQ) * DM + h * 64; GAS const bf16* vbase = VB + (size_t)(b * SEQ) * DM + h * 64;
    for (int jb = 0; jb <= qb; ++jb) {
        if (!((sel >> jb) & 1u)) continue;
        for (int i = 0; i < 4; ++i) { const int key = jb * 256 + i * 64 + lane; const bool valid = key <= t; KEY_UPDATE(kbase + (size_t)key * DM, vbase + (size_t)key * DM, valid); }
    }
    WAVE_FINISH(QO + (size_t)m * DM + h * 64, ss + (size_t)m * 16 + h);
}
__device__ __forceinline__ void dil_naive_one(int w, int lane, GAS bf16* QO, GAS const bf16* KB, GAS const bf16* VB, GAS float* ss) {
    const int t = w & (SEQ - 1), h = (w >> 12) & 7, b = w >> 15, m = b * SEQ + t;
    LOAD_Q(QO + (size_t)m * DM + 512 + h * 64);
    float ov[64]; float mrun = -INFINITY, lrun = 0.f;
#pragma unroll
    for (int d = 0; d < 64; ++d) ov[d] = 0.f;
    GAS const bf16* kbase = KB + (size_t)(b * SEQ) * DM + 512 + h * 64; GAS const bf16* vbase = VB + (size_t)(b * SEQ) * DM + 512 + h * 64;
    for (int cfg = 0; cfg < 3; ++cfg) {
        const int dil = cfg == 0 ? 1 : (cfg == 1 ? 4 : 16);
        for (int i = 0; i < 3; ++i) { const int n = i * 64 + lane; const int key = t - dil * n; const bool valid = (n < 129) && (key >= 0); const int keyc = key < 0 ? 0 : key;
            KEY_UPDATE(kbase + (size_t)keyc * DM, vbase + (size_t)keyc * DM, valid); }
    }
    WAVE_FINISH(QO + (size_t)m * DM + 512 + h * 64, ss + (size_t)m * 16 + 8 + h);
}

struct Args { const float* in[10]; float* out; unsigned char* ws; int ph_lo, ph_hi, li, pad; };
constexpr int PH_PER_LAYER = 6, N_PHASES = 1 + DEPTH * PH_PER_LAYER + 1;
typedef GAS float gf32; typedef GAS const float gcf32; typedef GAS bf16 gbf16; typedef GAS f32x4 gf32x4; typedef GAS const f32x4 gcf32x4;

__global__ void __launch_bounds__(NWAVES * 64, 2) fwd_kernel(Args args) {
    extern __shared__ __attribute__((aligned(16))) unsigned char lds[];
    LAS unsigned char* L = (LAS unsigned char*)lds;
    volatile LAS unsigned* MISC = (volatile LAS unsigned*)(L + MISC_OFF);
    const int G = gridDim.x; const int bx = blockIdx.x;
    const int wave_s = __builtin_amdgcn_readfirstlane(threadIdx.x >> 6);
    gu32* ctl = (gu32*)(args.ws + WS_CTL);
    for (int u = threadIdx.x; u < (LDS_BYTES - LDSCTL_OFF) / 4; u += NWAVES * 64) ((LAS unsigned*)(L + LDSCTL_OFF))[u] = 0u;
    __syncthreads();
    XcdBarrier bar; bar.bar = (unsigned*)(ctl + CW_BAR) + args.li * XCD_BAR_WORDS; bar.x = 0; bar.st = nullptr;
    if (!MK_PER_PHASE) bar = xcd_barrier_post((unsigned*)(ctl + CW_BAR) + args.li * XCD_BAR_WORDS, MISC + 8);
    const int lo = args.ph_lo, hi = args.ph_hi; (void)lo; (void)hi;
#define IN(k) (lo <= (k) && (k) < hi)
#define SEAM(k) do { if (IN(k) && IN((k) + 1)) { xcd_barrier(bar); if (PROBE_PHASE == 6) xcd_barrier(bar); } } while (0)
#define OPAQUE_S(p) asm volatile("" : "+s"(p))
#define PHASE_IDS() \
    int lane_; asm volatile("v_mbcnt_lo_u32_b32 %0, -1, 0\n\tv_mbcnt_hi_u32_b32 %0, -1, %0" : "=v"(lane_)); const int lane = lane_, wave = wave_s, tid = wave * 64 + lane; (void)tid; \
    const int vcu = (G % 8 == 0) ? (bx % 8) * (G / 8) + bx / 8 : bx; const int gw = vcu * NWAVES + wave, NGW = G * NWAVES; (void)lane; (void)gw; (void)NGW
#define PHASE_PTRS() \
    unsigned char* ws_ = args.ws; OPAQUE_S(ws_); GAS unsigned char* ws = (GAS unsigned char*)ws_; float* xres_ = args.out; OPAQUE_S(xres_); gf32* xres = (gf32*)xres_; \
    gf32* cs = (gf32*)(ws + WS_CS); gf32* stA = (gf32*)(ws + WS_STA); gf32* stB = (gf32*)(ws + WS_STB); gf32* ss = (gf32*)(ws + WS_SS); gf32* kmean = (gf32*)(ws + WS_KM); \
    gbf16* xb = (gbf16*)(ws + WS_XB); gbf16* QO = (gbf16*)(ws + WS_QO); gbf16* KB = (gbf16*)(ws + WS_KB); gbf16* VB = (gbf16*)(ws + WS_VB); gbf16* HB = (gbf16*)(ws + WS_H); \
    (void)cs; (void)stA; (void)stB; (void)ss; (void)kmean; (void)xb; (void)QO; (void)KB; (void)VB; (void)HB; (void)xres
#define LAYERW(l) LayerW{(gcf32*)args.in[1] + (size_t)(l) * DM, (gcf32*)args.in[2] + (size_t)(l) * DM * NQKV, (gcf32*)args.in[3] + (size_t)(l) * 512, (gcf32*)args.in[4] + (size_t)(l) * 512, \
                         (gcf32*)args.in[5] + (size_t)(l) * DM * DM, (gcf32*)args.in[6] + (size_t)(l) * DM, (gcf32*)args.in[7] + (size_t)(l) * DM * DFF, (gcf32*)args.in[8] + (size_t)(l) * DFF * DM}

    if (IN(0)) {
        PHASE_IDS(); PHASE_PTRS(); gcf32* x_in = (gcf32*)args.in[0];
        LAS float* scr = (LAS float*)(L + wave * 16384);
        for (int idx = bx * (NWAVES * 64) + tid; idx < SEQ * 32; idx += G * NWAVES * 64) {
            const int t = idx >> 5, i = idx & 31;
            const float inv = 1.0f / powf(10000.0f, (float)(2 * i) / 64.0f); const float ang = (float)t * inv;
            cs[idx] = cosf(ang); cs[SEQ * 32 + idx] = sinf(ang);
        }
        { const LayerW LW = LAYERW(0); convert_layer(LW, ws + WS_W, scr, gw, NGW, lane); }
        for (int row = gw; row < M; row += NGW) {
            gcf32x4* xr = (gcf32x4*)(x_in + (size_t)row * DM); float s = 0.f;
#pragma unroll
            for (int j = 0; j < 4; ++j) { const f32x4 v = xr[lane + 64 * j]; s += (v[0] * v[0] + v[1] * v[1]) + (v[2] * v[2] + v[3] * v[3]);
                v2u o; o.x = pk2(v[0], v[1]); o.y = pk2(v[2], v[3]); ((GAS v2u*)(xb + (size_t)row * DM))[lane + 64 * j] = o; }
            s = wave_sum(s);
            if (lane < 16) stA[(size_t)row * 16 + lane] = (lane == 0) ? s : 0.f;
        }
    }
    SEAM(0);

#pragma nounroll
    for (int l = 0; l < DEPTH; ++l) {
        const int p0 = 1 + l * PH_PER_LAYER;
        if (IN(p0)) {
            PHASE_PTRS(); GAS unsigned char* wb = ws + WS_W + (size_t)(l & 1) * W_BUF;
            pg8::Gemm g{(const bf16*)xb, (const bf16*)(wb + W_QKV), M, NQKV, DM}; pg8::StaticOrder S; S.init(M, NQKV, G, bx);
            pg8::EpiQKV E{QO, (size_t)(WS_KB - WS_QO) / 2, stA, cs, kmean};
            if (PROBE_PHASE == 10) { pg8::EpiNull Ed{(gf32*)(ws + 250 * MiB)}; pg8::gemm_phase<pg8::EpiNull, pg8::StaticOrder, true>(L, g, S, Ed, wave_s); }
#pragma nounroll
            for (int rep = 0; rep < (PROBE_PHASE == 0 ? 2 : 1); ++rep)
            pg8::gemm_phase<pg8::EpiQKV, pg8::StaticOrder, true>(L, g, S, E, wave_s);
        }
        SEAM(p0);
        if (IN(p0 + 1)) {
            PHASE_IDS(); PHASE_PTRS();
            LAS float* scr = (LAS float*)(L + wave * 16384);
#pragma nounroll
            for (int rep = 0; rep < (PROBE_PHASE == 1 ? 2 : 1); ++rep)
            if (l + 1 < DEPTH) { const LayerW LW = LAYERW(l + 1); convert_layer(LW, ws + WS_W + (size_t)((l + 1) & 1) * W_BUF, scr, gw, NGW, lane); }
            asm volatile("s_waitcnt vmcnt(0) lgkmcnt(0)\n\ts_barrier" ::: "memory");
            static_assert(dil3::RING_END <= RING_BYTES && RING_BYTES + 4096 + 16384 <= LDS_BYTES, "dilated staging vs LDS map");
            gbf16* Pout = (gbf16*)(ws + WS_PD); gf32* LSE = (gf32*)(ws + WS_LSE);
            float* wsf = (float*)((char*)lds + RING_BYTES + 1024) + wave * 64;
            const int nun = (G == 256) ? 6 : (BATCH * 8 * 48 - vcu + G - 1) / G;
#pragma nounroll
            for (int rep = 0; rep < ((PROBE_PHASE == 7 || PROBE_PHASE == 9) ? 2 : 1); ++rep)
            dil3::dil_phase((PROBE_PHASE == 9 && rep == 0) ? 255 : 0xffff, nun, G, vcu, SEQ, QO, KB, VB, Pout, PD_STRIDE, LSE, LSE_STRIDE, (char*)lds, (char*)lds + RING_BYTES + 4096, wsf, wave);
        }
        SEAM(p0 + 1);
        if (IN(p0 + 2)) {
            PHASE_IDS(); PHASE_PTRS();
            static_assert(attn_body::ATTN_LDS_BYTES <= RING_BYTES, "attention scratch vs LDS ring");
            const int nun = (G == 256) ? 2 : (BATCH * 8 * 16 - vcu + G - 1) / G;
            gbf16* Odum = (gbf16*)(ws + 234 * MiB); gf32* ssdum = (gf32*)(ws + 250 * MiB); (void)Odum; (void)ssdum;
#pragma nounroll
            for (int rep = 0; rep < (PROBE_PHASE == 2 ? 2 : 1); ++rep)
#pragma nounroll
            for (int i = 0; i < nun; ++i) {
                int bh, qb;
                if (G == 256) { bh = vcu >> 3; qb = (i == 0) ? 15 - (vcu & 7) : (vcu & 7); } else { const int u = vcu + i * G; bh = u >> 4; qb = u & 15; }
                const bool dum = (PROBE_PHASE == 2) && rep == 0;
                attn_body::moba_unit<8>(bh >> 3, bh & 7, qb, SEQ, QO, KB, VB, dum ? Odum : QO, kmean, dum ? ssdum : ss, (char*)lds, wave);
            }
            { gbf16* Pout = (gbf16*)(ws + WS_PD); gf32* LSE = (gf32*)(ws + WS_LSE);
              int lane; asm volatile("v_mbcnt_lo_u32_b32 %0, -1, 0\n\tv_mbcnt_hi_u32_b32 %0, -1, %0" : "=v"(lane));
#pragma nounroll
              for (int rep = 0; rep < (PROBE_PHASE == 8 ? 2 : 1); ++rep)
              for (int row = gw; row < M; row += NGW) dil2::dil_combine_row(row, lane, Pout, LSE, PD_STRIDE, LSE_STRIDE, QO, ss); }
        }
        SEAM(p0 + 2);
        if (IN(p0 + 3)) {
            PHASE_PTRS(); GAS unsigned char* wb = ws + WS_W + (size_t)(l & 1) * W_BUF;
            pg8::Gemm g{(const bf16*)QO, (const bf16*)(wb + W_O), M, DM, DM}; pg8::StaticOrder S; S.init(M, DM, G, bx);
            pg8::EpiRes<true> E{xb, stB, ss};
            pg8::gemm_phase<pg8::EpiRes<true>, pg8::StaticOrder, false>(L, g, S, E, wave_s);
        }
        SEAM(p0 + 3);
        if (IN(p0 + 4)) {
            PHASE_PTRS(); GAS unsigned char* wb = ws + WS_W + (size_t)(l & 1) * W_BUF;
            pg8::Gemm g{(const bf16*)xb, (const bf16*)(wb + W_UP), M, DFF, DM}; pg8::StaticOrder S; S.init(M, DFF, G, bx);
            pg8::EpiUp E{HB, stB};
#pragma nounroll
            for (int rep = 0; rep < (PROBE_PHASE == 4 ? 2 : 1); ++rep)
            pg8::gemm_phase<pg8::EpiUp, pg8::StaticOrder, true>(L, g, S, E, wave_s);
        }
        SEAM(p0 + 4);
        if (IN(p0 + 5)) {
            PHASE_PTRS(); GAS unsigned char* wb = ws + WS_W + (size_t)(l & 1) * W_BUF;
            pg8::Gemm g{(const bf16*)HB, (const bf16*)(wb + W_DN), M, DM, DFF}; pg8::StaticOrder S; S.init(M, DM, G, bx);
            pg8::EpiRes<false> E{xb, stA, nullptr};
            pg8::gemm_phase<pg8::EpiRes<false>, pg8::StaticOrder, false>(L, g, S, E, wave_s);
        }
        SEAM(p0 + 5);
    }
    if (IN(N_PHASES - 1)) {
        PHASE_IDS(); PHASE_PTRS(); gcf32* gfin = (gcf32*)args.in[9];
        for (int row = gw; row < M; row += NGW) {
            gf32x4* xr = (gf32x4*)(xres + (size_t)row * DM);
            const float r = pg8::row_rs(stA, row, 1.0f / DM);
#pragma unroll
            for (int j = 0; j < 4; ++j) { const v2u bw = ((GAS const v2u*)(xb + (size_t)row * DM))[lane + 64 * j]; const f32x4 gg = ((gcf32x4*)gfin)[lane + 64 * j];
                const f32x4 v = {bf2f(bw.x & 0xffffu), bf2f(bw.x >> 16), bf2f(bw.y & 0xffffu), bf2f(bw.y >> 16)}; xr[lane + 64 * j] = v * r * gg; }
        }
    }
#undef IN
#undef SEAM
}

extern "C" void kernel_launch(void* const* d_in, const int* in_sizes, int n_in, void* d_out, int out_size, void* d_ws, size_t ws_size, hipStream_t stream) {
    static int grid = 0;
    if (grid == 0) {
        if (n_in != 10 || out_size != M * DM || ws_size < WS_END) { fprintf(stderr, "kernel_launch: unexpected shapes (n_in %d out %d ws %zu)\n", n_in, out_size, ws_size); grid = -1; return; }
        int dev = 0, cus = 0, per_cu = 0;
        if (hipGetDevice(&dev) != hipSuccess || hipDeviceGetAttribute(&cus, hipDeviceAttributeMultiprocessorCount, dev) != hipSuccess) { grid = -1; return; }
        if (hipFuncSetAttribute((const void*)fwd_kernel, hipFuncAttributeMaxDynamicSharedMemorySize, LDS_BYTES) != hipSuccess) { fprintf(stderr, "kernel_launch: hipFuncSetAttribute failed\n"); grid = -1; return; }
        if (hipOccupancyMaxActiveBlocksPerMultiprocessor(&per_cu, (const void*)fwd_kernel, NWAVES * 64, LDS_BYTES) != hipSuccess || per_cu < 1)
            fprintf(stderr, "kernel_launch: note: occupancy query reports %d workgroups per CU\n", per_cu);
        (void)hipGetLastError();
        grid = cus;
    }
    if (grid < 0) return;
    if (hipMemsetAsync((char*)d_ws + WS_CTL, 0, CTL_ZERO_BYTES, stream) != hipSuccess) { fprintf(stderr, "kernel_launch: memset failed\n"); return; }
    Args a{};
    for (int i = 0; i < 10; ++i) a.in[i] = (const float*)d_in[i];
    a.out = (float*)d_out; a.ws = (unsigned char*)d_ws;
#if MK_PER_PHASE
    for (int p = 0; p < N_PHASES; ++p) { a.ph_lo = p; a.ph_hi = p + 1; a.li = 0; hipLaunchKernelGGL(fwd_kernel, dim3(grid), dim3(NWAVES * 64), LDS_BYTES, stream, a); }
#else
    a.ph_lo = 0; a.ph_hi = N_PHASES; a.li = 0;
    hipLaunchKernelGGL(fwd_kernel, dim3(grid), dim3(NWAVES * 64), LDS_BYTES, stream, a);
#endif
    const hipError_t le = hipPeekAtLastError();
    if (le != hipSuccess) fprintf(stderr, "kernel_launch: launch failed: %s\n", hipGetErrorName(le));
}
```

```cpp
#include <hip/hip_runtime.h>
#include <cstdio>
#include <cstdint>

#ifndef PROBE_PHASE
#define PROBE_PHASE -1
#endif
#ifndef MK_PER_PHASE
#define MK_PER_PHASE 0
#endif

constexpr int BATCH = 4, SEQ = 4096, DM = 1024, DEPTH = 4, DFF = 4096, M = BATCH * SEQ, NQKV = 3072;
constexpr float NORM_EPS = 1e-6f;
constexpr float C2 = 0.125f * 1.4426950408889634f;

namespace pg8 {
#define PG8_LAS __attribute__((address_space(3)))
typedef unsigned short bf16_t;
typedef short bf16x8 __attribute__((ext_vector_type(8)));
typedef float f32x4 __attribute__((ext_vector_type(4)));
typedef unsigned u32x4 __attribute__((ext_vector_type(4)));
#define PG8_GAS __attribute__((address_space(1)))
typedef PG8_GAS float gf32; typedef PG8_GAS const float gcf32; typedef PG8_GAS bf16_t gbf16;
typedef PG8_GAS f32x4 gf32x4; typedef PG8_GAS const f32x4 gcf32x4; typedef PG8_GAS u32x4 gu32x4;
constexpr int BM = 256, BK = 64, HALF = 128, HTB = HALF * BK * 2, STAGE_BYTES = 8 * HTB, NXCD = 8, WGM = 8;

__host__ __device__ __forceinline__ int lds_byte(int r, int c) { const int st = (r >> 4) * 2 + (c >> 5), rr = r & 15, cc = c & 31, ob = rr * 64 + cc * 2; return st * 1024 + (ob ^ (((ob >> 9) & 1) << 5)); }
__host__ __device__ __forceinline__ void stage_rc(int b, int& R, int& C) { const int st = b / 1024, sb = b % 1024, swz = sb ^ (((sb >> 9) & 1) << 5); R = (st >> 1) * 16 + swz / 64; C = (st & 1) * 32 + (swz % 64) / 2; }
__host__ __device__ __forceinline__ int perm32(int rho) { const int n = rho >> 4, i = rho & 15; return 8 * (i >> 2) + 4 * n + (i & 3); }

struct Unit { int pm, pn; };
struct Gemm { const bf16_t* A; const bf16_t* Bt; int M, N, K; };

struct StaticOrder {
    int nM, nN, nwg, G, c;
    __host__ __device__ void init(int M_, int N_, int G_, int c_) { nM = M_ / BM; nN = N_ / BM; nwg = nM * nN; G = G_; c = c_; }
    __host__ __device__ bool next(int i, Unit& u) const {
        const long L = (long)i * G + c; if (L >= nwg) return false;
        int wgid = (int)L; { const int q = nwg / NXCD, r = nwg % NXCD, xcd = wgid % NXCD, off = wgid / NXCD; wgid = (xcd < r ? xcd * (q + 1) : r * (q + 1) + (xcd - r) * q) + off; }
        const int nig = WGM * nN, gid = wgid / nig, fm = gid * WGM, gsz = (nM - fm) < WGM ? (nM - fm) : WGM;
        u.pm = fm + ((wgid % nig) % gsz); u.pn = (wgid % nig) / gsz; return true;
    }
    __device__ __forceinline__ void a_ready(const Unit&) const {}
    __device__ __forceinline__ void done(const Unit&) const {}
};

__device__ __forceinline__ unsigned cvt_pk_bf16(float lo, float hi) { unsigned r; asm volatile("v_cvt_pk_bf16_f32 %0, %1, %2" : "=v"(r) : "v"(lo), "v"(hi)); return r; }

__device__ __forceinline__ int lane_id_now() { int l; asm volatile("v_mbcnt_lo_u32_b32 %0, -1, 0\n\tv_mbcnt_hi_u32_b32 %0, -1, %0" : "=v"(l)); return l; }
#define PG8_FRESH_LANE() const int lane_f = lane_id_now(), fr = lane_f & 15, fq = lane_f >> 4
__device__ __forceinline__ float row_rs(gcf32* stats, int row, float inv_n) {
    gcf32x4* p = (gcf32x4*)(stats + (size_t)row * 16);
    const f32x4 a = p[0], b = p[1], c = p[2], d = p[3];
    const float s = ((a[0] + a[1]) + (a[2] + a[3])) + ((b[0] + b[1]) + (b[2] + b[3])) + ((c[0] + c[1]) + (c[2] + c[3])) + ((d[0] + d[1]) + (d[2] + d[3]));
    return 1.0f / sqrtf(s * inv_n + NORM_EPS);
}


__device__ __forceinline__ f32x4 stats_part(gcf32* stats, int row, int fq) { return *(gcf32x4*)(stats + (size_t)row * 16 + 4 * fq); }
__device__ __forceinline__ float stats_sum(f32x4 a) { float t = (a[0] + a[1]) + (a[2] + a[3]); t += __shfl_xor(t, 16); t += __shfl_xor(t, 32); return t; }

struct EpiQKV {
    static constexpr bool PERM = true, AFTER_DRAIN = false, MID = false;
    gbf16* Q; size_t arr_stride; gcf32* stats; PG8_GAS const unsigned* csh; gf32* kpart;
    __device__ __forceinline__ void mid(f32x4 (&)[2][2][4][2], const Unit&, int, int, int, int) const {}
    __device__ __forceinline__ void operator()(const f32x4 (&acc)[2][2][4][2], const Unit& u, int wr, int wc, int, int) const {
        PG8_FRESH_LANE();
        const int arr = u.pn >> 2;
        gbf16* base = Q + (size_t)arr * arr_stride;
        const int col0 = (u.pn & 3) * 256 + 64 * wc + 8 * fq;
        const float qs = arr == 0 ? C2 : 1.0f;
        const bool ksum = (arr == 1) && ((u.pn & 3) < 2);
        f32x4 cs0 = {0.f, 0.f, 0.f, 0.f}, cs1 = cs0, cs2 = cs0, cs3 = cs0;
        float rsv[8];
        { f32x4 sp[8];
#pragma unroll
          for (int k = 0; k < 8; ++k) sp[k] = stats_part(stats, u.pm * BM + (k >> 2) * HALF + wr * 64 + (k & 3) * 16 + fr, fq);
#pragma unroll
          for (int k = 0; k < 8; ++k) rsv[k] = qs / sqrtf(stats_sum(sp[k]) * (1.0f / DM) + NORM_EPS); }
#pragma unroll
        for (int ai = 0; ai < 2; ++ai) {
            const int row0 = u.pm * BM + ai * HALF + wr * 64 + fr;
            u32x4 tc0[4], tc1[4];
            if (arr < 2) {
#pragma unroll
                for (int m = 0; m < 4; ++m) { const int t = (row0 + m * 16) & (SEQ - 1);
                    tc0[m] = *(PG8_GAS const u32x4*)(csh + t * 32 + 8 * fq); tc1[m] = *(PG8_GAS const u32x4*)(csh + t * 32 + 8 * fq + 4); }
            }
#pragma unroll
            for (int m = 0; m < 4; ++m) {
                const int row = row0 + m * 16;
                const float rs = rsv[ai * 4 + m];
                f32x4 l0 = acc[ai][0][m][0] * rs, l1 = acc[ai][0][m][1] * rs, h0 = acc[ai][1][m][0] * rs, h1 = acc[ai][1][m][1] * rs;
                if (arr < 2) {
#define H_LO(u_) ((float)__builtin_bit_cast(_Float16, (unsigned short)((u_) & 0xffffu)))
#define H_HI(u_) ((float)__builtin_bit_cast(_Float16, (unsigned short)((u_) >> 16)))
                    const u32x4 ta = tc0[m], tb = tc1[m];
                    const f32x4 c0 = {H_LO(ta.x), H_LO(ta.y), H_LO(ta.z), H_LO(ta.w)}, s0 = {H_HI(ta.x), H_HI(ta.y), H_HI(ta.z), H_HI(ta.w)};
                    const f32x4 c1 = {H_LO(tb.x), H_LO(tb.y), H_LO(tb.z), H_LO(tb.w)}, s1 = {H_HI(tb.x), H_HI(tb.y), H_HI(tb.z), H_HI(tb.w)};
#undef H_LO
#undef H_HI
                    const f32x4 o0 = l0 * c0 - h0 * s0, o1 = l1 * c1 - h1 * s1, p0 = h0 * c0 + l0 * s0, p1 = h1 * c1 + l1 * s1;
                    l0 = o0; l1 = o1; h0 = p0; h1 = p1;
                }
                cs0 += l0; cs1 += l1; cs2 += h0; cs3 += h1;
                gbf16* rowp = base + (size_t)row * DM + col0;
                u32x4 w; w.x = cvt_pk_bf16(l0[0], l0[1]); w.y = cvt_pk_bf16(l0[2], l0[3]); w.z = cvt_pk_bf16(l1[0], l1[1]); w.w = cvt_pk_bf16(l1[2], l1[3]);
                *(gu32x4*)rowp = w;
                w.x = cvt_pk_bf16(h0[0], h0[1]); w.y = cvt_pk_bf16(h0[2], h0[3]); w.z = cvt_pk_bf16(h1[0], h1[1]); w.w = cvt_pk_bf16(h1[2], h1[3]);
                *(gu32x4*)(rowp + 32) = w;
            }
            asm volatile("" ::: "memory");
        }
        if (ksum) {
#pragma unroll
            for (int o = 1; o < 16; o <<= 1)
#pragma unroll
                for (int i = 0; i < 4; ++i) { cs0[i] += __shfl_xor(cs0[i], o); cs1[i] += __shfl_xor(cs1[i], o); cs2[i] += __shfl_xor(cs2[i], o); cs3[i] += __shfl_xor(cs3[i], o); }
            if (fr == 0) {
                const int b = u.pm >> 4, j = u.pm & 15, head = (u.pn & 3) * 4 + wc;
                gf32* kp = kpart + ((size_t)((b * 8 + head) * 16 + j) * 2 + wr) * 64 + 8 * fq;
                *(gf32x4*)kp = cs0; *(gf32x4*)(kp + 4) = cs1; *(gf32x4*)(kp + 32) = cs2; *(gf32x4*)(kp + 36) = cs3;
            }
        }
    }
};

struct EpiUp {
    static constexpr bool PERM = true, AFTER_DRAIN = false, MID = false;
    gbf16* H; gcf32* stats;
    __device__ __forceinline__ void mid(f32x4 (&)[2][2][4][2], const Unit&, int, int, int, int) const {}
    __device__ __forceinline__ void operator()(const f32x4 (&acc)[2][2][4][2], const Unit& u, int wr, int wc, int, int) const {
        PG8_FRESH_LANE();
        const int col0 = u.pn * BM + wc * 32 + 8 * fq;
        const int row0 = u.pm * BM + wr * 64 + fr;
        f32x4 sp[8];
#pragma unroll
        for (int k = 0; k < 8; ++k) sp[k] = stats_part(stats, row0 + (k >> 2) * HALF + (k & 3) * 16, fq);
#pragma unroll
        for (int ai = 0; ai < 2; ++ai)
#pragma unroll
            for (int m = 0; m < 4; ++m) {
                const int row = row0 + ai * HALF + m * 16;
                const float rs = 1.0f / sqrtf(stats_sum(sp[ai * 4 + m]) * (1.0f / DM) + NORM_EPS);
                gbf16* rowp = H + (size_t)row * DFF + col0;
#pragma unroll
                for (int bj = 0; bj < 2; ++bj) {
                    f32x4 v0 = acc[ai][bj][m][0] * rs, v1 = acc[ai][bj][m][1] * rs;
#pragma unroll
                    for (int i = 0; i < 4; ++i) { const float a = fmaxf(v0[i], 0.f), b = fmaxf(v1[i], 0.f); v0[i] = a * a; v1[i] = b * b; }
                    u32x4 w; w.x = cvt_pk_bf16(v0[0], v0[1]); w.y = cvt_pk_bf16(v0[2], v0[3]); w.z = cvt_pk_bf16(v1[0], v1[1]); w.w = cvt_pk_bf16(v1[2], v1[3]);
                    *(gu32x4*)(rowp + bj * HALF) = w;
                }
            }
    }
};

struct EpiNull {
    static constexpr bool PERM = true, AFTER_DRAIN = false, MID = false;
    gf32* dummy;
    __device__ __forceinline__ void mid(f32x4 (&)[2][2][4][2], const Unit&, int, int, int, int) const {}
    __device__ __forceinline__ void operator()(const f32x4 (&acc)[2][2][4][2], const Unit& u, int wr, int wc, int, int) const {
        f32x4 t = {0.f, 0.f, 0.f, 0.f};
#pragma unroll
        for (int ai = 0; ai < 2; ++ai)
#pragma unroll
            for (int bj = 0; bj < 2; ++bj)
#pragma unroll
                for (int m = 0; m < 4; ++m)
#pragma unroll
                    for (int n = 0; n < 2; ++n) t += acc[ai][bj][m][n];
        const float v = (t[0] + t[1]) + (t[2] + t[3]);
        if (v == 12345.678f) dummy[u.pm * 4 + u.pn] = v;
    }
};

template <bool TWO_SCALE> struct EpiRes {
    static constexpr bool PERM = true, AFTER_DRAIN = false, MID = TWO_SCALE;
    gbf16* xb; gf32* stats_out; gcf32* ss;
    __device__ __forceinline__ void half_scales(f32x4 part, int fq, float& ra, float& rd) const {
        float t = (part[0] + part[1]) + (part[2] + part[3]); t += __shfl_xor(t, 16);
        const float o = __shfl_xor(t, 32);
        const float sa = fq < 2 ? t : o, sd = fq < 2 ? o : t;
        ra = 1.0f / sqrtf(sa * (1.0f / 512.0f) + NORM_EPS); rd = 1.0f / sqrtf(sd * (1.0f / 512.0f) + NORM_EPS);
    }
    __device__ __forceinline__ void mid(f32x4 (&acc)[2][2][4][2], const Unit& u, int wr, int wc, int, int) const {
        if constexpr (TWO_SCALE) {
            PG8_FRESH_LANE();
            const int row0 = u.pm * BM + wr * 64 + fr;
            f32x4 sp[8];
#pragma unroll
            for (int k = 0; k < 8; ++k) sp[k] = stats_part(ss, row0 + (k >> 2) * HALF + (k & 3) * 16, fq);
#pragma unroll
            for (int ai = 0; ai < 2; ++ai)
#pragma unroll
                for (int m = 0; m < 4; ++m) {
                    float ra, rd; half_scales(sp[ai * 4 + m], fq, ra, rd); const float f = ra / rd;
#pragma unroll
                    for (int bj = 0; bj < 2; ++bj)
#pragma unroll
                        for (int n = 0; n < 2; ++n) acc[ai][bj][m][n] = acc[ai][bj][m][n] * f;
                }
        }
    }
    __device__ __forceinline__ void operator()(const f32x4 (&acc)[2][2][4][2], const Unit& u, int wr, int wc, int, int) const {
        PG8_FRESH_LANE();
        const int col0 = u.pn * BM + wc * 32 + 8 * fq;
#pragma unroll
        for (int ai = 0; ai < 2; ++ai) {
            const int row0 = u.pm * BM + ai * HALF + wr * 64 + fr;
            u32x4 bw[4][2]; f32x4 sp[4];
#pragma unroll
            for (int m = 0; m < 4; ++m) {
                bw[m][0] = *(gu32x4*)(xb + (size_t)(row0 + m * 16) * DM + col0); bw[m][1] = *(gu32x4*)(xb + (size_t)(row0 + m * 16) * DM + col0 + HALF);
                if constexpr (TWO_SCALE) sp[m] = stats_part(ss, row0 + m * 16, fq);
            }
#pragma unroll
            for (int m = 0; m < 4; ++m) {
                const int row = row0 + m * 16;
                float rd = 1.0f; if constexpr (TWO_SCALE) { float ra; half_scales(sp[m], fq, ra, rd); }
                const size_t off = (size_t)row * DM + col0; float sq = 0.f;
#pragma unroll
                for (int bj = 0; bj < 2; ++bj) {
                    const u32x4 b = bw[m][bj];
                    const f32x4 b0 = {__builtin_bit_cast(float, b.x << 16), __builtin_bit_cast(float, b.x & 0xffff0000u), __builtin_bit_cast(float, b.y << 16), __builtin_bit_cast(float, b.y & 0xffff0000u)};
                    const f32x4 b1 = {__builtin_bit_cast(float, b.z << 16), __builtin_bit_cast(float, b.z & 0xffff0000u), __builtin_bit_cast(float, b.w << 16), __builtin_bit_cast(float, b.w & 0xffff0000u)};
                    const f32x4 x0 = b0 + acc[ai][bj][m][0] * rd, x1 = b1 + acc[ai][bj][m][1] * rd;
                    sq += ((x0[0] * x0[0] + x0[1] * x0[1]) + (x0[2] * x0[2] + x0[3] * x0[3])) + ((x1[0] * x1[0] + x1[1] * x1[1]) + (x1[2] * x1[2] + x1[3] * x1[3]));
                    u32x4 w; w.x = cvt_pk_bf16(x0[0], x0[1]); w.y = cvt_pk_bf16(x0[2], x0[3]); w.z = cvt_pk_bf16(x1[0], x1[1]); w.w = cvt_pk_bf16(x1[2], x1[3]);
                    *(gu32x4*)(xb + off + bj * HALF) = w;
                }
                sq += __shfl_xor(sq, 16); sq += __shfl_xor(sq, 32);
                if (fq == 0) stats_out[(size_t)row * 16 + u.pn * 4 + wc] = sq;
            }
            asm volatile("" ::: "memory");
        }
    }
};

template <class Epi, class Sched, bool ALIGN_EPI>
__device__ __forceinline__ void gemm_phase(PG8_LAS unsigned char* lds, const Gemm g, const Sched& S, const Epi& E, const int wid_  ) {
    int lane_; asm volatile("v_mbcnt_lo_u32_b32 %0, -1, 0\n\tv_mbcnt_hi_u32_b32 %0, -1, %0" : "=v"(lane_));
    int wid_o = wid_; asm volatile("" : "+s"(wid_o));
    const int lane = lane_, wid = wid_o, tid = wid * 64 + lane, wr = wid >> 2, wc = wid & 3, fr = lane & 15, fq = lane >> 4;
    const int K = g.K, nt = K / BK;
    unsigned voffA[2], voffB[2];
#pragma unroll
    for (int i = 0; i < 2; ++i) { int R, C; stage_rc(tid * 16 + i * 8192, R, C); const int Rb = Epi::PERM ? ((R & ~31) + perm32(R & 31)) : R;
        voffA[i] = (unsigned)(R * K + C) * 2u; voffB[i] = (unsigned)(Rb * K + C) * 2u; }
    const size_t kstep = (size_t)(BK * 2);
    const size_t hstep = (size_t)HALF * K * 2;
    const size_t tstep = 2 * hstep;
    const unsigned ldsw = (unsigned)wid * 1024u;
    const int aoff = lds_byte(wr * 64 + fr, fq * 8), boff = lds_byte(wc * 32 + fr, fq * 8);
#define PG8_SA(b, h) (((b) * 2 + (h)) * HTB)
#define PG8_SB(b, h) ((4 + (b) * 2 + (h)) * HTB)
#define PG8_STAGE(bufoff, gbase, voff) do { _Pragma("unroll") for (int _i = 0; _i < 2; ++_i) \
        __builtin_amdgcn_global_load_lds((const unsigned*)((const char*)(gbase) + (voff)[_i]), (PG8_LAS unsigned*)(lds + (bufoff) + ldsw + _i * 8192), 16, 0, 0); } while (0)
#define PG8_LDA(dst, b, h) do { _Pragma("unroll") for (int m = 0; m < 4; ++m) _Pragma("unroll") for (int k = 0; k < 2; ++k) dst[m][k] = *(const PG8_LAS bf16x8*)(lds + PG8_SA(b, h) + aoff + m * 2048 + k * 1024); } while (0)
#define PG8_LDB(dst, b, h) do { _Pragma("unroll") for (int n = 0; n < 2; ++n) _Pragma("unroll") for (int k = 0; k < 2; ++k) dst[n][k] = *(const PG8_LAS bf16x8*)(lds + PG8_SB(b, h) + boff + n * 2048 + k * 1024); } while (0)
#define PG8_MMA(ai, bj, At, Bt) do { __builtin_amdgcn_s_setprio(1); _Pragma("unroll") for (int m = 0; m < 4; ++m) _Pragma("unroll") for (int n = 0; n < 2; ++n) _Pragma("unroll") for (int k = 0; k < 2; ++k) \
        acc[ai][bj][m][n] = __builtin_amdgcn_mfma_f32_16x16x32_bf16(Bt[n][k], At[m][k], acc[ai][bj][m][n], 0, 0, 0); __builtin_amdgcn_s_setprio(0); } while (0)
#define PG8_WAIT_V(n) asm volatile("s_waitcnt vmcnt(" #n ")" ::: "memory")
#define PG8_WAIT_L(n) asm volatile("s_waitcnt lgkmcnt(" #n ")" ::: "memory")
#define PG8_BAR __builtin_amdgcn_s_barrier()
#define PG8_SCHED __builtin_amdgcn_sched_barrier(0)
    Unit cur, nxt; int ui = 0;
    if (!S.next(0, cur)) return;
    f32x4 acc[2][2][4][2];
#pragma unroll
    for (int a = 0; a < 2; ++a)
#pragma unroll
        for (int b = 0; b < 2; ++b)
#pragma unroll
            for (int m = 0; m < 4; ++m)
#pragma unroll
                for (int n = 0; n < 2; ++n) acc[a][b][m][n] = (f32x4){0.f, 0.f, 0.f, 0.f};
    bf16x8 At[4][2], B0[2][2], B1[2][2];
    const char* cA = (const char*)g.A + (size_t)cur.pm * tstep; const char* cB = (const char*)g.Bt + (size_t)cur.pn * tstep;
    S.a_ready(cur);
    PG8_STAGE(PG8_SB(0, 0), cB, voffB); PG8_STAGE(PG8_SB(0, 1), cB + hstep, voffB); PG8_STAGE(PG8_SA(0, 0), cA, voffA); PG8_STAGE(PG8_SA(0, 1), cA + hstep, voffA);
    if (wr == 1) PG8_BAR;
    PG8_WAIT_V(2); PG8_BAR;
    PG8_STAGE(PG8_SB(1, 0), cB + kstep, voffB); PG8_STAGE(PG8_SA(1, 0), cA + kstep, voffA); PG8_STAGE(PG8_SB(1, 1), cB + hstep + kstep, voffB);
    PG8_WAIT_V(6); PG8_BAR;
    for (;;) {
        const bool has_next = S.next(ui + 1, nxt);
        const char* nA = has_next ? (const char*)g.A + (size_t)nxt.pm * tstep : cA; const char* nB = has_next ? (const char*)g.Bt + (size_t)nxt.pn * tstep : cB;
        for (int t = 0; t < nt; t += 2) {
            if constexpr (Epi::MID) { if (t == (nt >> 1)) { E.mid(acc, cur, wr, wc, fr, fq); PG8_SCHED; } }
            const bool last = (t == nt - 2);
            const char* a1 = cA + (size_t)(t + 1) * kstep;
            const char* a2 = last ? nA : cA + (size_t)(t + 2) * kstep; const char* b2 = last ? nB : cB + (size_t)(t + 2) * kstep;
            const char* a3 = a2 + kstep; const char* b3 = b2 + kstep;
            if (last && has_next) S.a_ready(nxt);
            PG8_LDB(B0, 0, 0); PG8_LDB(B1, 0, 1); PG8_SCHED; PG8_LDA(At, 0, 0); PG8_STAGE(PG8_SA(1, 1), a1 + hstep, voffA);
            PG8_WAIT_V(8); PG8_WAIT_L(0); PG8_BAR; PG8_MMA(0, 0, At, B0); PG8_MMA(0, 1, At, B1); PG8_BAR; PG8_SCHED;
            PG8_LDA(At, 0, 1); PG8_STAGE(PG8_SB(0, 0), b2, voffB); PG8_STAGE(PG8_SB(0, 1), b2 + hstep, voffB); PG8_STAGE(PG8_SA(0, 0), a2, voffA);
            PG8_WAIT_V(8); PG8_WAIT_L(0); PG8_BAR; PG8_MMA(1, 0, At, B0); PG8_MMA(1, 1, At, B1); PG8_BAR; PG8_SCHED;
            PG8_LDB(B0, 1, 0); PG8_LDB(B1, 1, 1); PG8_SCHED; PG8_LDA(At, 1, 0); PG8_STAGE(PG8_SA(0, 1), a2 + hstep, voffA);
            PG8_WAIT_V(8); PG8_WAIT_L(0); PG8_BAR; PG8_MMA(0, 0, At, B0); PG8_MMA(0, 1, At, B1); PG8_BAR; PG8_SCHED;
            PG8_LDA(At, 1, 1); PG8_STAGE(PG8_SB(1, 0), b3, voffB); PG8_STAGE(PG8_SB(1, 1), b3 + hstep, voffB); PG8_STAGE(PG8_SA(1, 0), a3, voffA);
            PG8_WAIT_V(8); PG8_WAIT_L(0); PG8_BAR; PG8_MMA(1, 0, At, B0); PG8_MMA(1, 1, At, B1); PG8_BAR; PG8_SCHED;
        }
        if constexpr (ALIGN_EPI) { if (wr == 0) PG8_BAR; }
        E(acc, cur, wr, wc, fr, fq); S.done(cur);
        if (!has_next) break;
#pragma unroll
        for (int a = 0; a < 2; ++a)
#pragma unroll
            for (int b = 0; b < 2; ++b)
#pragma unroll
                for (int m = 0; m < 4; ++m)
#pragma unroll
                    for (int n = 0; n < 2; ++n) acc[a][b][m][n] = (f32x4){0.f, 0.f, 0.f, 0.f};
        cur = nxt; cA = nA; cB = nB; ++ui;
        if constexpr (ALIGN_EPI) { if (wr == 1) PG8_BAR; }
    }
    PG8_WAIT_V(0);
    if constexpr (!ALIGN_EPI) { if (wr == 0) PG8_BAR; }
    PG8_BAR;
#undef PG8_SA
#undef PG8_SB
#undef PG8_STAGE
#undef PG8_LDA
#undef PG8_LDB
#undef PG8_MMA
#undef PG8_WAIT_V
#undef PG8_WAIT_L
#undef PG8_BAR
#undef PG8_SCHED
}
}

namespace attn_body {
using bf16x8=__attribute__((ext_vector_type(8)))short;
using s16x4=__attribute__((ext_vector_type(4)))short;
using f32x16=__attribute__((ext_vector_type(16)))float;
using u32x4=__attribute__((ext_vector_type(4)))unsigned;
using f32x4=__attribute__((ext_vector_type(4)))float;
typedef unsigned short bf16;
#define AGAS __attribute__((address_space(1)))
constexpr int D=64,DMP=1024;
constexpr int NW=8,QBLK=32,QB=QBLK*NW,KVBLK=64;
__device__ __forceinline__ int crow(int r,int hi){return (r&3)+8*(r>>2)+4*hi;}
#define SBAR() __builtin_amdgcn_sched_barrier(0)
__device__ __forceinline__ void cmask(f32x16&p0,f32x16&p1,int jb,int qrel,int hi){
  const float NEG=-INFINITY; int kb=64*jb+4*hi;
  #pragma unroll
  for(int r=0;r<16;++r){int kv=kb+(r&3)+8*(r>>2); if(kv>qrel)p0[r]=NEG; if(kv+32>qrel)p1[r]=NEG;}
}
constexpr int NSLOT=3, SLOTB=8192;
constexpr int LDS_K=0, LDS_V=NSLOT*SLOTB, LDS_WS=2*NSLOT*SLOTB, LDS_OST=LDS_WS+NW*64*4, LDS_BYTES=LDS_OST+NW*4096;
__device__ __forceinline__ void glds16(const void*gsrc,unsigned lds_dst){unsigned keep;
  asm volatile("s_mov_b32 %0, m0\n\ts_mov_b32 m0, %2\n\ts_nop 0\n\tglobal_load_lds_dwordx4 %1, off\n\ts_mov_b32 m0, %0":"=&s"(keep):"v"(gsrc),"s"(lds_dst):"memory");}
__device__ __forceinline__ float max3f(float a,float b,float c){float r;asm("v_max3_f32 %0, %1, %2, %3":"=v"(r):"v"(a),"v"(b),"v"(c));return r;}
__device__ __forceinline__ float max2f(float a,float b){float r;asm("v_max_f32_e32 %0, %1, %2":"=v"(r):"v"(a),"v"(b));return r;}
__device__ __forceinline__ float fadd_s(float a,float b){float r;asm("v_add_f32_e32 %0, %1, %2":"=v"(r):"v"(a),"v"(b));return r;}
__device__ __forceinline__ float fsub_s(float a,float b){float r;asm("v_sub_f32_e32 %0, %1, %2":"=v"(r):"v"(a),"v"(b));return r;}
typedef float f32x2_t __attribute__((ext_vector_type(2))); typedef __bf16 bf16x2_t __attribute__((ext_vector_type(2)));
__device__ __forceinline__ unsigned cvtpk_s(float lo,float hi){f32x2_t v={lo,hi};bf16x2_t b=__builtin_convertvector(v,bf16x2_t);return __builtin_bit_cast(unsigned,b);}
#define WAIT_BAR(N) asm volatile("s_waitcnt vmcnt(" #N ") lgkmcnt(0)\n\ts_barrier":::"memory")
__device__ __forceinline__ void qkt(f32x16&p0,f32x16&p1,const char*Kslot,const bf16x8*qr,const f32x16&negm,int r32,int hi){
  const char*kb=Kslot+(r32>>3)*1024+((hi^((r32>>3)&1))*128)+(r32&7)*16;
  #pragma unroll
  for(int d0=0;d0<4;++d0){
    const bf16x8 b0=*reinterpret_cast<const bf16x8*>(kb+d0*256);
    const bf16x8 b1=*reinterpret_cast<const bf16x8*>(kb+d0*256+4096);
    if(d0==0){p0=__builtin_amdgcn_mfma_f32_32x32x16_bf16(b0,qr[0],negm,0,0,0);p1=__builtin_amdgcn_mfma_f32_32x32x16_bf16(b1,qr[0],negm,0,0,0);}
    else{p0=__builtin_amdgcn_mfma_f32_32x32x16_bf16(b0,qr[d0],p0,0,0,0);p1=__builtin_amdgcn_mfma_f32_32x32x16_bf16(b1,qr[d0],p1,0,0,0);}}
}
typedef __attribute__((address_space(3))) const char* lds_cptr;
typedef short v4i16_t __attribute__((ext_vector_type(4)));
__device__ __forceinline__ void kload8(bf16x8*kf,lds_cptr kp){
  kf[0]=*(const __attribute__((address_space(3))) bf16x8*)(kp);      kf[1]=*(const __attribute__((address_space(3))) bf16x8*)(kp+4096);
  kf[2]=*(const __attribute__((address_space(3))) bf16x8*)(kp+256);  kf[3]=*(const __attribute__((address_space(3))) bf16x8*)(kp+4352);
  kf[4]=*(const __attribute__((address_space(3))) bf16x8*)(kp+512);  kf[5]=*(const __attribute__((address_space(3))) bf16x8*)(kp+4608);
  kf[6]=*(const __attribute__((address_space(3))) bf16x8*)(kp+768);  kf[7]=*(const __attribute__((address_space(3))) bf16x8*)(kp+4864);
}
__device__ __forceinline__ void kload2(bf16x8*kf,lds_cptr kp,int j){ kf[2*j]=*(const __attribute__((address_space(3))) bf16x8*)(kp+j*256); kf[2*j+1]=*(const __attribute__((address_space(3))) bf16x8*)(kp+j*256+4096); }
__device__ __forceinline__ s16x4 vtr(lds_cptr p){ return __builtin_bit_cast(s16x4,__builtin_amdgcn_ds_read_tr16_b64_v4i16((__attribute__((address_space(3))) v4i16_t*)p)); }
__device__ __forceinline__ float rowmax(const f32x16&p0,const f32x16&p1){
  float a=max3f(p0[0],p0[1],p1[0]),b=max3f(p0[2],p0[3],p1[1]);a=max3f(a,p1[2],p1[3]);
  #pragma unroll
  for(int r=4;r<16;r+=4){a=max3f(a,p0[r],p0[r+1]);b=max3f(b,p0[r+2],p0[r+3]);a=max3f(a,p1[r],p1[r+1]);b=max3f(b,p1[r+2],p1[r+3]);}
  const float m=max2f(a,b);
  auto rr=__builtin_amdgcn_permlane32_swap(__float_as_uint(m),__float_as_uint(m),false,false);
  return max2f(__uint_as_float(rr[0]),__uint_as_float(rr[1]));
}
__device__ __forceinline__ void pv(f32x16*o,int vb,bf16x8 pa0,bf16x8 pa1,bf16x8 pa2,bf16x8 pa3){
  #pragma unroll
  for(int d0=0;d0<2;++d0){s16x4 lo[4],hi[4];
    #pragma unroll
    for(int ks=0;ks<4;++ks){
      asm volatile("ds_read_b64_tr_b16 %0,%1 offset:%c2":"=&v"(lo[ks]):"v"(vb),"i"(d0*512+ks*2048):"memory");
      asm volatile("ds_read_b64_tr_b16 %0,%1 offset:%c2":"=&v"(hi[ks]):"v"(vb),"i"(d0*512+ks*2048+1024):"memory");}
    asm volatile("s_waitcnt lgkmcnt(0)":::"memory");SBAR();
    #define PK(k) (bf16x8){lo[k][0],lo[k][1],lo[k][2],lo[k][3],hi[k][0],hi[k][1],hi[k][2],hi[k][3]}
    o[d0]=__builtin_amdgcn_mfma_f32_32x32x16_bf16(pa0,PK(0),o[d0],0,0,0);
    o[d0]=__builtin_amdgcn_mfma_f32_32x32x16_bf16(pa1,PK(1),o[d0],0,0,0);
    o[d0]=__builtin_amdgcn_mfma_f32_32x32x16_bf16(pa2,PK(2),o[d0],0,0,0);
    o[d0]=__builtin_amdgcn_mfma_f32_32x32x16_bf16(pa3,PK(3),o[d0],0,0,0);
    #undef PK
  }
}
__device__ __forceinline__ int lane_now(){ int l; asm volatile("v_mbcnt_lo_u32_b32 %0, -1, 0\n\tv_mbcnt_hi_u32_b32 %0, -1, %0":"=v"(l)); return l; }
__device__ __forceinline__ unsigned short f2bf_s(float f){ unsigned u=__builtin_bit_cast(unsigned,f); return (unsigned short)((u+0x7fffu+((u>>16)&1u))>>16); }

template<int THRL> __device__ __forceinline__ void moba_unit(int b,int h,int qb,int SEQL,AGAS const bf16*Q,AGAS const bf16*K,AGAS const bf16*V,AGAS bf16*O,AGAS const float*kpart,AGAS float*ss,char*shm,const int wid){
  int lane_; asm volatile("v_mbcnt_lo_u32_b32 %0, -1, 0\n\tv_mbcnt_hi_u32_b32 %0, -1, %0":"=v"(lane_));
  const int lane=lane_,r32=lane&31,hi=lane>>5;
  const long rowbase=(long)b*SEQL; const int q0=qb*QB;
  AGAS const bf16*Qw=Q+(rowbase+q0+wid*QBLK)*DMP+h*D;
  AGAS const bf16*Kh=K+rowbase*DMP+h*D; AGAS const bf16*Vh=V+rowbase*DMP+h*D;
  const unsigned lds0=(unsigned)(uintptr_t)shm;
  float*wsf=(float*)(shm+LDS_WS)+wid*64;
  AGAS const bf16*ksrc=Kh+(long)(8*wid+(lane&7))*DMP+(((lane>>3)^(wid&1))*8);
  AGAS const bf16*vsrc=Vh+(long)(8*wid+((lane>>2)&7))*DMP+(lane>>5)*32+(lane&3)*8;
  const unsigned kdst=lds0+LDS_K+wid*1024, vdst=lds0+LDS_V+wid*1024;
  #define DMA_K(t,slot) glds16((const void*)(ksrc+(long)(t)*KVBLK*DMP),(unsigned)__builtin_amdgcn_readfirstlane(kdst+(slot)))
  #define DMA_V(t,slot) glds16((const void*)(vsrc+(long)(t)*KVBLK*DMP),(unsigned)__builtin_amdgcn_readfirstlane(vdst+(slot)))
  const char*Kbase=shm+LDS_K; bf16x8 kf[8];
  const lds_cptr shm3=(lds_cptr)shm; const lds_cptr kp0=shm3+LDS_K+(r32>>3)*1024+((hi^((r32>>3)&1))*128)+(r32&7)*16; const lds_cptr vp0=shm3+LDS_V+((lane>>4)&1)*32+(lane&3)*8+(4*hi+((lane&15)>>2))*64;
  const int NT=(q0+QB)/KVBLK;
  DMA_K(0,0);DMA_V(0,0);DMA_K(1,SLOTB);
  bf16x8 qr[4];
  #pragma unroll
  for(int d0=0;d0<4;++d0)qr[d0]=*reinterpret_cast<AGAS const bf16x8*>(&Qw[(long)r32*DMP+d0*16+hi*8]);
  unsigned selbits=1u<<qb;
  if(qb>0){
    f32x16 g=f32x16{};
    { AGAS const float*kp=kpart+((size_t)((b*8+h)*16+(r32&15))*2)*64+8*hi;
      #pragma unroll
      for(int d0=0;d0<4;++d0){
        f32x4 a0=*(AGAS const f32x4*)(kp+16*d0),a1=*(AGAS const f32x4*)(kp+16*d0+4),c0=*(AGAS const f32x4*)(kp+64+16*d0),c1=*(AGAS const f32x4*)(kp+64+16*d0+4);
        a0=(a0+c0)*(1.0f/256.0f); a1=(a1+c1)*(1.0f/256.0f);
        if(r32>=16){a0=f32x4{0.f,0.f,0.f,0.f};a1=a0;}
        bf16x8 kh,kl;
        #pragma unroll
        for(int i=0;i<4;++i){ const unsigned short h0=f2bf_s(a0[i]),h1=f2bf_s(a1[i]); kh[i]=(short)h0; kh[4+i]=(short)h1;
          kl[i]=(short)f2bf_s(a0[i]-__builtin_bit_cast(float,(unsigned)h0<<16)); kl[4+i]=(short)f2bf_s(a1[i]-__builtin_bit_cast(float,(unsigned)h1<<16)); }
        g=__builtin_amdgcn_mfma_f32_32x32x16_bf16(kh,qr[d0],g,0,0,0);
        g=__builtin_amdgcn_mfma_f32_32x32x16_bf16(kl,qr[d0],g,0,0,0);
      } }
    float gv[16];
    #pragma unroll
    for(int r=0;r<8;++r){ auto rr=__builtin_amdgcn_permlane32_swap(__float_as_uint(g[r]),__float_as_uint(g[r]),false,false);
      const int j0=(r&3)+8*(r>>2); gv[j0]=(j0<qb)?__uint_as_float(rr[0]):-1e30f; gv[j0+4]=(j0+4<qb)?__uint_as_float(rr[1]):-1e30f; }
    unsigned sel=0u;
    #pragma unroll
    for(int rep=0;rep<3;++rep){ float best=-INFINITY; int bi=0;
      #pragma unroll
      for(int j=0;j<16;++j){ const bool ok=!((sel>>j)&1u); if(ok&&gv[j]>best){best=gv[j];bi=j;} }
      sel|=1u<<bi; }
    selbits=(sel&((1u<<qb)-1u))|(1u<<qb);
  }
  #define MASKOF(tt) ((unsigned)(-(int)((selbits>>((tt)>>2))&1u)))
  #define SELOF(tt) (((selbits>>((tt)>>2))&1u)!=0u)
  float mhat=0.f,l_reg=0.f;f32x16 o[2];o[0]=f32x16{};o[1]=f32x16{};f32x16 negm=f32x16{};asm volatile("":"+v"(negm));
  const int qrel=wid*QBLK+r32;
  #define CMASK(P0,P1,t) do{int jb_=(t)-(NT-4); if(jb_>=0)cmask(P0,P1,jb_,qrel,hi);}while(0)
  bool resc=false;
  #define START(P0,P1) do{ const float rm=rowmax(P0,P1); resc=false; \
    { const float dl=rm; mhat=fadd_s(mhat,dl); \
      _Pragma("unroll") for(int r=0;r<16;++r){P0[r]=fsub_s(P0[r],dl);P1[r]=fsub_s(P1[r],dl);} \
      _Pragma("unroll") for(int r=0;r<16;++r)negm[r]=-mhat; asm volatile("":"+v"(negm)); } \
    _Pragma("unroll") for(int r=0;r<16;++r)P0[r]=__builtin_amdgcn_exp2f(P0[r]); }while(0)
  #define RESC() do{ if(resc){ asm volatile("s_waitcnt lgkmcnt(0)":::"memory"); const float*wr_=wsf+4*(lane_now()>>5); \
      _Pragma("unroll") for(int d_=0;d_<2;++d_) _Pragma("unroll") for(int r=0;r<16;++r)o[d_][r]*=wr_[crow(r,0)]; } }while(0)
  f32x16 pA0,pA1,pB0,pB1;
  int sl_prev=0,sl_cur=0,sl_next=SLOTB;
  #define ROT() do{sl_prev=sl_cur;sl_cur=sl_next;sl_next=(sl_next==(NSLOT-1)*SLOTB)?0:sl_next+SLOTB;}while(0)
  DMA_K(2,2*SLOTB);
  WAIT_BAR(3);
  qkt(pA0,pA1,Kbase,qr,negm,r32,hi);asm volatile("s_nop 15\n\ts_nop 7":"+v"(pA0),"+v"(pA1));CMASK(pA0,pA1,0);
  START(pA0,pA1);
  _Pragma("unroll") for(int r=0;r<16;++r)pA1[r]=__builtin_amdgcn_exp2f(pA1[r]);
  WAIT_BAR(0);
  DMA_K(3,0);DMA_V(1,SLOTB);
  ROT();
  kload8(kf,kp0+sl_cur);
  WAIT_BAR(2);
  s16x4 vlo[8],vhi[8]; u32x4 pw0,pw1,pw2,pw3;
  #define PKW(P,B) cvtpk_s(P[B],P[B+1])
  #define PAF(k) __builtin_bit_cast(bf16x8,pw##k)
  #define VFR(i) (bf16x8){vlo[i][0],vlo[i][1],vlo[i][2],vlo[i][3],vhi[i][0],vhi[i][1],vhi[i][2],vhi[i][3]}
  #define PIN(x) asm volatile("":"+v"(x))
  #define MX3(a,b,c) __builtin_fmaxf(__builtin_fmaxf((a),(b)),(c))
  #define GAPA(MF,A0,A1,A2,A3,W0,W1,PW) do{ MF; sacc+=A0; sacc+=A1; sacc+=A2; sacc+=A3; PIN(sacc); W0; W1; PIN(PW); SBAR(); }while(0)
  #define EX(v) __builtin_amdgcn_exp2f(v)
  #define GAPB(MF,X,B) do{ MF; X[B]=EX(X[B]); X[B+1]=EX(X[B+1]); X[B+2]=EX(X[B+2]); X[B+3]=EX(X[B+3]); PIN(X); SBAR(); }while(0)
  #define VRD(i) do{ vlo[i]=vtr(vp_+(((i)>>2)*512+((i)&3)*2048)); vhi[i]=vtr(vp_+(((i)>>2)*512+((i)&3)*2048+1024)); }while(0)
  #define KRD(G,j) do{ if(G){ kload2(kf,kp0+sl_next,j); SBAR(); } }while(0)
  #define STEP(C0,C1,P0,P1,t,GK,GV,GL,MP,SC) do{ SBAR(); \
    const lds_cptr vp_=vp0+sl_prev; \
    VRD(0); SBAR(); float sacc=(P0[0]+P0[1]); \
    GAPA(C0=__builtin_amdgcn_mfma_f32_32x32x16_bf16(kf[0],qr[0],negm,0,0,0), P0[2],P0[3],P0[4],P0[5],     pw0[0]=PKW(P0,0), pw0[1]=PKW(P0,2), pw0); \
    VRD(4); SBAR(); GAPA(C1=__builtin_amdgcn_mfma_f32_32x32x16_bf16(kf[1],qr[0],negm,0,0,0), P0[6],P0[7],P0[8],P0[9],     pw0[2]=PKW(P0,4), pw0[3]=PKW(P0,6), pw0); \
    VRD(1); SBAR(); GAPA(C0=__builtin_amdgcn_mfma_f32_32x32x16_bf16(kf[2],qr[1],C0,0,0,0),   P0[10],P0[11],P0[12],P0[13], pw1[0]=PKW(P0,8), pw1[1]=PKW(P0,10), pw1); \
    VRD(5); SBAR(); GAPA(C1=__builtin_amdgcn_mfma_f32_32x32x16_bf16(kf[3],qr[1],C1,0,0,0),   P0[14],P0[15],P1[0],P1[1],   pw1[2]=PKW(P0,12),pw1[3]=PKW(P0,14), pw1); \
    VRD(2); SBAR(); GAPA(C0=__builtin_amdgcn_mfma_f32_32x32x16_bf16(kf[4],qr[2],C0,0,0,0),   P1[2],P1[3],P1[4],P1[5],     pw2[0]=PKW(P1,0), pw2[1]=PKW(P1,2), pw2); \
    VRD(6); SBAR(); GAPA(C1=__builtin_amdgcn_mfma_f32_32x32x16_bf16(kf[5],qr[2],C1,0,0,0),   P1[6],P1[7],P1[8],P1[9],     pw2[2]=PKW(P1,4), pw2[3]=PKW(P1,6), pw2); \
    VRD(3); SBAR(); GAPA(C0=__builtin_amdgcn_mfma_f32_32x32x16_bf16(kf[6],qr[3],C0,0,0,0),   P1[10],P1[11],P1[12],P1[13], pw3[0]=PKW(P1,8), pw3[1]=PKW(P1,10), pw3); \
    VRD(7); SBAR(); GAPA(C1=__builtin_amdgcn_mfma_f32_32x32x16_bf16(kf[7],qr[3],C1,0,0,0),   P1[14],P1[15],0.f,0.f,       pw3[2]=PKW(P1,12),pw3[3]=PKW(P1,14), pw3); \
    { const unsigned mp_=(MP); l_reg+=__uint_as_float(__float_as_uint(sacc)&mp_); pw0&=mp_; pw1&=mp_; pw2&=mp_; pw3&=mp_; } \
    if(GK){DMA_K((t)+3,sl_cur);} if(GV){DMA_V((t)+1,sl_next);} \
    CMASK(C0,C1,t); \
    { float a=MX3(C0[0],C0[1],C1[0]),b=MX3(C0[2],C0[3],C1[1]); a=MX3(a,C1[2],C1[3]); \
      _Pragma("unroll") for(int r=4;r<16;r+=4){a=MX3(a,C0[r],C0[r+1]);b=MX3(b,C0[r+2],C0[r+3]);a=MX3(a,C1[r],C1[r+1]);b=MX3(b,C1[r+2],C1[r+3]);} \
      float rm=__builtin_fmaxf(a,b); { auto rr=__builtin_amdgcn_permlane32_swap(__float_as_uint(rm),__float_as_uint(rm),false,false); rm=__builtin_fmaxf(__uint_as_float(rr[0]),__uint_as_float(rr[1])); } \
      rm=(SC)?rm:-INFINITY; \
      resc=false; \
      if(__builtin_expect(__any(rm>(float)THRL),0)){ const float dl=__builtin_fmaxf(rm,0.f); mhat+=dl; \
        _Pragma("unroll") for(int r=0;r<16;++r){C0[r]-=dl;C1[r]-=dl;} \
        _Pragma("unroll") for(int r=0;r<16;++r)negm[r]=-mhat; asm volatile("":"+v"(negm)); \
        const float f=__builtin_amdgcn_exp2f(-dl); l_reg*=f; { const int ln_=lane_now(); if(ln_<32)wsf[ln_]=f; } resc=true; } } \
    SBAR(); \
    GAPB(o[0]=__builtin_amdgcn_mfma_f32_32x32x16_bf16(PAF(0),VFR(0),o[0],0,0,0), C0,0); \
    GAPB(o[1]=__builtin_amdgcn_mfma_f32_32x32x16_bf16(PAF(0),VFR(4),o[1],0,0,0), C0,4); \
    KRD(GL,0); GAPB(o[0]=__builtin_amdgcn_mfma_f32_32x32x16_bf16(PAF(1),VFR(1),o[0],0,0,0), C0,8); \
    KRD(GL,1); GAPB(o[1]=__builtin_amdgcn_mfma_f32_32x32x16_bf16(PAF(1),VFR(5),o[1],0,0,0), C0,12); \
    KRD(GL,2); GAPB(o[0]=__builtin_amdgcn_mfma_f32_32x32x16_bf16(PAF(2),VFR(2),o[0],0,0,0), C1,0); \
    KRD(GL,3); GAPB(o[1]=__builtin_amdgcn_mfma_f32_32x32x16_bf16(PAF(2),VFR(6),o[1],0,0,0), C1,4); \
    GAPB(o[0]=__builtin_amdgcn_mfma_f32_32x32x16_bf16(PAF(3),VFR(3),o[0],0,0,0), C1,8); \
    GAPB(o[1]=__builtin_amdgcn_mfma_f32_32x32x16_bf16(PAF(3),VFR(7),o[1],0,0,0), C1,12); \
    }while(0)
  int t=1;
  #undef CMASK
  #define CMASK(P0,P1,t) do{}while(0)
  for(;t+5<NT;t+=2){
    STEP(pB0,pB1,pA0,pA1,t,true,true,true,MASKOF(t-1),SELOF(t));     WAIT_BAR(2); RESC(); ROT();
    STEP(pA0,pA1,pB0,pB1,t+1,true,true,true,MASKOF(t),SELOF(t+1));   WAIT_BAR(2); RESC(); ROT();
  }
  #undef CMASK
  #define CMASK(P0,P1,t) do{int jb_=(t)-(NT-4); if(jb_>=0)cmask(P0,P1,jb_,qrel,hi);}while(0)
  #define ENDW(tt) do{ if((tt)+3<NT){WAIT_BAR(2);} else if((tt)+2<NT){WAIT_BAR(1);} else {WAIT_BAR(0);} }while(0)
  for(;t+1<NT;t+=2){
    STEP(pB0,pB1,pA0,pA1,t,(t+3<NT),(t+1<NT),(t+1<NT),MASKOF(t-1),SELOF(t));       ENDW(t);   RESC(); ROT();
    STEP(pA0,pA1,pB0,pB1,t+1,(t+4<NT),(t+2<NT),(t+2<NT),MASKOF(t),SELOF(t+1));     ENDW(t+1); RESC(); ROT();
  }
  STEP(pB0,pB1,pA0,pA1,NT-1,false,false,false,MASKOF(NT-2),true); RESC();
  { float sacc=pB0[0]+pB0[1]; _Pragma("unroll") for(int r=2;r<16;++r)sacc+=pB0[r]; _Pragma("unroll") for(int r=0;r<16;++r)sacc+=pB1[r]; l_reg+=sacc;
    pw0=(u32x4){PKW(pB0,0),PKW(pB0,2),PKW(pB0,4),PKW(pB0,6)};pw1=(u32x4){PKW(pB0,8),PKW(pB0,10),PKW(pB0,12),PKW(pB0,14)};pw2=(u32x4){PKW(pB1,0),PKW(pB1,2),PKW(pB1,4),PKW(pB1,6)};pw3=(u32x4){PKW(pB1,8),PKW(pB1,10),PKW(pB1,12),PKW(pB1,14)};
    const int ln_=lane_now(); const int vb0=(int)(lds0+LDS_V)+((ln_>>4)&1)*32+(ln_&3)*8+(4*(ln_>>5)+((ln_&15)>>2))*64;
    SBAR(); pv(o,vb0+sl_cur,PAF(0),PAF(1),PAF(2),PAF(3)); }
  #undef PKW
  #undef PAF
  #undef VFR
  #undef PIN
  #undef MX3
  #undef GAPA
  #undef GAPB
  #undef EX
  #undef VRD
  #undef KRD
  #undef STEP
  #undef ENDW
  {auto rr=__builtin_amdgcn_permlane32_swap(__float_as_uint(l_reg),__float_as_uint(l_reg),false,false);l_reg=__uint_as_float(rr[0])+__uint_as_float(rr[1]);}
  if(hi==0)wsf[32+r32]=l_reg;asm volatile("s_waitcnt lgkmcnt(0)":::"memory");
  float rli[16];
  #pragma unroll
  for(int r=0;r<16;++r)rli[r]=__builtin_amdgcn_rcpf(wsf[32+crow(r,hi)]);
  AGAS bf16*Ow=O+(rowbase+q0+wid*QBLK)*DMP+h*D;
  { bf16*stg=(bf16*)(shm+LDS_OST)+wid*2048;
    #pragma unroll
    for(int r=0;r<16;++r){const int orow=crow(r,hi);
      #pragma unroll
      for(int d0=0;d0<2;++d0)stg[orow*64+d0*32+r32]=f2bf_s(o[d0][r]*rli[r]);}
    asm volatile("s_waitcnt lgkmcnt(0)":::"memory");
    #pragma unroll
    for(int i=0;i<4;++i){const int row=i*8+(lane>>3),ch=lane&7; const u32x4 v=*(const u32x4*)(stg+row*64+ch*8); *(AGAS u32x4*)(Ow+(long)row*DMP+ch*8)=v;
      float sq=0.f;
      #pragma unroll
      for(int e=0;e<4;++e){ const float lo=__builtin_bit_cast(float,v[e]<<16), hi2=__builtin_bit_cast(float,v[e]&0xffff0000u); sq+=lo*lo+hi2*hi2; }
      sq+=__shfl_xor(sq,1); sq+=__shfl_xor(sq,2); sq+=__shfl_xor(sq,4);
      if(ch==0) ss[(size_t)(rowbase+q0+wid*QBLK+row)*16+h]=sq; } }
  asm volatile("s_waitcnt lgkmcnt(0)\n\ts_barrier":::"memory");
  #undef DMA_K
  #undef DMA_V
  #undef CMASK
  #undef START
  #undef RESC
  #undef ROT
  #undef MASKOF
  #undef SELOF
}
constexpr int ATTN_LDS_BYTES=LDS_BYTES;
#undef SBAR
#undef WAIT_BAR
}

namespace dil_body {
using attn_body::bf16x8; using attn_body::s16x4; using attn_body::f32x16; using attn_body::u32x4; using attn_body::bf16; using attn_body::lds_cptr;
using attn_body::crow; using attn_body::glds16; using attn_body::vtr; using attn_body::cvtpk_s; using attn_body::f2bf_s;
constexpr int NGRP=33, WBUF=8192, WLDS=2*WBUF;
#define DGAS __attribute__((address_space(1)))
#define DLAS __attribute__((address_space(3)))
template<int THRL> __device__ __forceinline__ void dil_item(int b,int h,int blk,int r,int SEQL,DGAS const bf16*Q,DGAS const bf16*K,DGAS const bf16*V,DGAS bf16*O,DGAS float*ss,char*wlds,float*wsf){
  int lane_; asm volatile("v_mbcnt_lo_u32_b32 %0, -1, 0\n\tv_mbcnt_hi_u32_b32 %0, -1, %0":"=v"(lane_));
  const int lane=lane_,r32=lane&31,hi=lane>>5;
  const int T0=blk*512, tq=T0+r+16*r32; const long rowbase=(long)b*SEQL;
  DGAS const bf16*Qrow=Q+(rowbase+tq)*1024+512+h*64;
  DGAS const bf16*Kh=K+rowbase*1024+512+h*64; DGAS const bf16*Vh=V+rowbase*1024+512+h*64;
  bf16x8 qr[4];
  #pragma unroll
  for(int d0=0;d0<4;++d0)qr[d0]=*reinterpret_cast<DGAS const bf16x8*>(Qrow+d0*16+hi*8);
  asm volatile("s_waitcnt vmcnt(0)":"+v"(qr[0]),"+v"(qr[1]),"+v"(qr[2]),"+v"(qr[3])::"memory");
  const unsigned lds0=(unsigned)(uintptr_t)wlds; const lds_cptr w3=(lds_cptr)wlds;
  #define GPARAMS(gi,base,sh,W) int base,sh,W; if((gi)<5){sh=4;base=T0+r-2048+512*(gi);W=2048;} else if((gi)<13){sh=2;base=T0+(r&3)-512+128*((gi)-5);W=512;} else {sh=0;base=T0+r-128+32*((gi)-13);W=128;}
  #define CLAMPT(x) ((x)<0?0:((x)>SEQL-1?SEQL-1:(x)))
  #define ISSUE(gi,buf) do{ GPARAMS(gi,base_,sh_,W_); (void)W_; \
      const int tk_=CLAMPT(base_+((lane&31)<<sh_)); DGAS const bf16*ks_=Kh+(long)tk_*1024+(lane>>5)*8; \
      const int tv0_=CLAMPT(base_+((lane>>2)<<sh_)), tv1_=CLAMPT(base_+(((lane>>2)+16)<<sh_)); \
      DGAS const bf16*vs0_=Vh+(long)tv0_*1024+(lane&3)*8; DGAS const bf16*vs1_=Vh+(long)tv1_*1024+(lane&3)*8; \
      const unsigned kd_=(unsigned)__builtin_amdgcn_readfirstlane(lds0+(buf)*WBUF), vd_=kd_+4096; \
      glds16((const void*)(ks_),kd_); glds16((const void*)(ks_+16),kd_+1024); glds16((const void*)(ks_+32),kd_+2048); glds16((const void*)(ks_+48),kd_+3072); \
      glds16((const void*)(vs0_),vd_); glds16((const void*)(vs1_),vd_+1024); glds16((const void*)(vs0_+32),vd_+2048); glds16((const void*)(vs1_+32),vd_+3072); }while(0)
  float mhat=0.f,l_reg=0.f; f32x16 o[2]; o[0]=f32x16{}; o[1]=f32x16{}; f32x16 negm=f32x16{};
  ISSUE(0,0);
  #pragma nounroll
  for(int gi=0;gi<NGRP;++gi){
    const int buf=gi&1;
    if(gi+1<NGRP){ ISSUE(gi+1,buf^1); asm volatile("s_waitcnt vmcnt(8)":::"memory"); } else { asm volatile("s_waitcnt vmcnt(0)":::"memory"); }
    const lds_cptr kp=w3+buf*WBUF+hi*512+r32*16;
    f32x16 p;
    { const bf16x8 k0=*(DLAS const bf16x8*)(kp), k1=*(DLAS const bf16x8*)(kp+1024), k2=*(DLAS const bf16x8*)(kp+2048), k3=*(DLAS const bf16x8*)(kp+3072);
      p=__builtin_amdgcn_mfma_f32_32x32x16_bf16(k0,qr[0],negm,0,0,0); p=__builtin_amdgcn_mfma_f32_32x32x16_bf16(k1,qr[1],p,0,0,0);
      p=__builtin_amdgcn_mfma_f32_32x32x16_bf16(k2,qr[2],p,0,0,0); p=__builtin_amdgcn_mfma_f32_32x32x16_bf16(k3,qr[3],p,0,0,0); }
    { GPARAMS(gi,base,sh,W); const unsigned bound=(unsigned)(W<tq?W:tq); const int dl0=tq-base-((4*hi)<<sh);
      #pragma unroll
      for(int rr=0;rr<16;++rr){ const int dlt=dl0-(((rr&3)+8*(rr>>2))<<sh); if((unsigned)dlt>bound)p[rr]=-INFINITY; } }
    float rm=p[0];
    #pragma unroll
    for(int rr=1;rr<16;++rr)rm=__builtin_fmaxf(rm,p[rr]);
    { auto sw=__builtin_amdgcn_permlane32_swap(__float_as_uint(rm),__float_as_uint(rm),false,false); rm=__builtin_fmaxf(__uint_as_float(sw[0]),__uint_as_float(sw[1])); }
    bool resc=false;
    if(gi==0){ const float dl=(rm>-INFINITY)?rm:0.f; mhat=dl;
      #pragma unroll
      for(int rr=0;rr<16;++rr){p[rr]-=dl; negm[rr]=-mhat;} }
    else if(__any(rm>(float)THRL)){ const float dl=__builtin_fmaxf(rm,0.f); mhat+=dl;
      #pragma unroll
      for(int rr=0;rr<16;++rr){p[rr]-=dl; negm[rr]=-mhat;}
      const float f=__builtin_amdgcn_exp2f(-dl); l_reg*=f; if(hi==0)wsf[r32]=f; resc=true; }
    float sacc=0.f;
    #pragma unroll
    for(int rr=0;rr<16;++rr){p[rr]=__builtin_amdgcn_exp2f(p[rr]); sacc+=p[rr];}
    l_reg+=sacc;
    if(resc){ asm volatile("s_waitcnt lgkmcnt(0)":::"memory");
      #pragma unroll
      for(int d_=0;d_<2;++d_)
        #pragma unroll
        for(int rr=0;rr<16;++rr)o[d_][rr]*=wsf[crow(rr,hi)]; }
    u32x4 pw0,pw1;
    pw0=(u32x4){cvtpk_s(p[0],p[1]),cvtpk_s(p[2],p[3]),cvtpk_s(p[4],p[5]),cvtpk_s(p[6],p[7])};
    pw1=(u32x4){cvtpk_s(p[8],p[9]),cvtpk_s(p[10],p[11]),cvtpk_s(p[12],p[13]),cvtpk_s(p[14],p[15])};
    const lds_cptr vp=w3+buf*WBUF+4096+((lane>>4)&1)*32+(lane&3)*8+(4*hi+((lane&15)>>2))*64;
    #pragma unroll
    for(int d0=0;d0<2;++d0){
      const s16x4 a0=vtr(vp+d0*2048), a1=vtr(vp+d0*2048+512), c0=vtr(vp+d0*2048+1024), c1=vtr(vp+d0*2048+1536);
      const bf16x8 v0=(bf16x8){a0[0],a0[1],a0[2],a0[3],a1[0],a1[1],a1[2],a1[3]}, v1=(bf16x8){c0[0],c0[1],c0[2],c0[3],c1[0],c1[1],c1[2],c1[3]};
      o[d0]=__builtin_amdgcn_mfma_f32_32x32x16_bf16(__builtin_bit_cast(bf16x8,pw0),v0,o[d0],0,0,0);
      o[d0]=__builtin_amdgcn_mfma_f32_32x32x16_bf16(__builtin_bit_cast(bf16x8,pw1),v1,o[d0],0,0,0); }
    asm volatile("s_waitcnt lgkmcnt(0)":::"memory");
  }
  {auto sw=__builtin_amdgcn_permlane32_swap(__float_as_uint(l_reg),__float_as_uint(l_reg),false,false);l_reg=__uint_as_float(sw[0])+__uint_as_float(sw[1]);}
  if(hi==0)wsf[32+r32]=l_reg; asm volatile("s_waitcnt lgkmcnt(0)":::"memory");
  float rli[16];
  #pragma unroll
  for(int rr=0;rr<16;++rr)rli[rr]=__builtin_amdgcn_rcpf(wsf[32+crow(rr,hi)]);
  { bf16*stg=(bf16*)wlds;
    #pragma unroll
    for(int rr=0;rr<16;++rr){const int orow=crow(rr,hi);
      #pragma unroll
      for(int d0=0;d0<2;++d0)stg[orow*64+d0*32+r32]=f2bf_s(o[d0][rr]*rli[rr]);}
    asm volatile("s_waitcnt lgkmcnt(0)":::"memory");
    #pragma unroll
    for(int i=0;i<4;++i){const int row=i*8+(lane>>3),ch=lane&7; const u32x4 v=*(const u32x4*)(stg+row*64+ch*8);
      const long grow=rowbase+T0+r+16*row;
      *(DGAS u32x4*)(O+grow*1024+512+h*64+ch*8)=v;
      float sq=0.f;
      #pragma unroll
      for(int e=0;e<4;++e){ const float lo=__builtin_bit_cast(float,v[e]<<16), hi2=__builtin_bit_cast(float,v[e]&0xffff0000u); sq+=lo*lo+hi2*hi2; }
      sq+=__shfl_xor(sq,1); sq+=__shfl_xor(sq,2); sq+=__shfl_xor(sq,4);
      if(ch==0) ss[(size_t)grow*16+8+h]=sq; }
    asm volatile("s_waitcnt lgkmcnt(0)":::"memory"); }
  #undef GPARAMS
  #undef CLAMPT
  #undef ISSUE
}
}

namespace dil2 {
using attn_body::bf16x8; using attn_body::s16x4; using attn_body::f32x16; using attn_body::u32x4; using attn_body::bf16; using attn_body::lds_cptr;
using attn_body::crow; using attn_body::glds16; using attn_body::vtr; using attn_body::cvtpk_s; using attn_body::f2bf_s;
constexpr int GB=8192, NG=12, STG_OFF=NG*GB, WS_OFF=STG_OFF+8*4096, LDS_BYTES=WS_OFF;
#define DGAS __attribute__((address_space(1)))
#define DLAS __attribute__((address_space(3)))
__device__ __forceinline__ void dil_unit(int b,int h,int cfg,int cl,int ch,int SEQL,DGAS const bf16*Q,DGAS const bf16*K,DGAS const bf16*V,DGAS bf16*Pout,DGAS float*LSE,char*shm,float*wsf,const int wid){
  int lane_; asm volatile("v_mbcnt_lo_u32_b32 %0, -1, 0\n\tv_mbcnt_hi_u32_b32 %0, -1, %0":"=v"(lane_));
  const int lane=lane_,r32=lane&31,hi=lane>>5;
  const int sh=2*cfg, j0=256*ch; const long rowbase=(long)b*SEQL;
  const int tq=cl+((j0+32*wid+r32)<<sh);
  DGAS const bf16*Qrow=Q+(rowbase+tq)*1024+512+h*64;
  DGAS const bf16*Kh=K+rowbase*1024+512+h*64; DGAS const bf16*Vh=V+rowbase*1024+512+h*64;
  bf16x8 qr[4];
  #pragma unroll
  for(int d0=0;d0<4;++d0)qr[d0]=*reinterpret_cast<DGAS const bf16x8*>(Qrow+d0*16+hi*8);
  const unsigned lds0=(unsigned)(uintptr_t)shm; const lds_cptr s3=(lds_cptr)shm;
  const int gfirst=(ch==0)?4:0;
  #pragma unroll
  for(int k=0;k<12;++k){ const int n=wid*12+k, g=n>>3, c=n&7;
    if(g>=gfirst){
      const int isv=c>>2, cc=c&3;
      const int row=isv?(16*(cc&1)+(lane>>2)):(lane&31);
      const int tk=cl+((j0-128+32*g+row)<<sh);
      DGAS const bf16*src=(isv?Vh:Kh)+(long)tk*1024+(isv?((cc>>1)*32+(lane&3)*8):((2*cc+(lane>>5))*8));
      glds16((const void*)src,(unsigned)__builtin_amdgcn_readfirstlane(lds0+g*GB+c*1024)); } }
  asm volatile("s_waitcnt vmcnt(0)":"+v"(qr[0]),"+v"(qr[1]),"+v"(qr[2]),"+v"(qr[3])::"memory");
  asm volatile("s_barrier":::"memory");
  f32x16 p[5];
  #pragma unroll
  for(int gg=0;gg<5;++gg){
    if(wid+gg>=gfirst){
      const lds_cptr kp=s3+(wid+gg)*GB+hi*512+r32*16;
      const bf16x8 k0=*(DLAS const bf16x8*)(kp), k1=*(DLAS const bf16x8*)(kp+1024), k2=*(DLAS const bf16x8*)(kp+2048), k3=*(DLAS const bf16x8*)(kp+3072);
      f32x16 a=f32x16{};
      a=__builtin_amdgcn_mfma_f32_32x32x16_bf16(k0,qr[0],a,0,0,0); a=__builtin_amdgcn_mfma_f32_32x32x16_bf16(k1,qr[1],a,0,0,0);
      a=__builtin_amdgcn_mfma_f32_32x32x16_bf16(k2,qr[2],a,0,0,0); a=__builtin_amdgcn_mfma_f32_32x32x16_bf16(k3,qr[3],a,0,0,0);
      p[gg]=a;
    } else {
      #pragma unroll
      for(int rr=0;rr<16;++rr)p[gg][rr]=-INFINITY; } }
  #pragma unroll
  for(int rr=0;rr<16;++rr){ const int kk=crow(rr,hi); if(kk<r32)p[0][rr]=-INFINITY; if(kk>r32)p[4][rr]=-INFINITY; }
  float rm=p[0][0];
  #pragma unroll
  for(int gg=0;gg<5;++gg)
    #pragma unroll
    for(int rr=0;rr<16;++rr)rm=__builtin_fmaxf(rm,p[gg][rr]);
  { auto sw=__builtin_amdgcn_permlane32_swap(__float_as_uint(rm),__float_as_uint(rm),false,false); rm=__builtin_fmaxf(__uint_as_float(sw[0]),__uint_as_float(sw[1])); }
  float l_reg=0.f;
  #pragma unroll
  for(int gg=0;gg<5;++gg)
    #pragma unroll
    for(int rr=0;rr<16;++rr){p[gg][rr]=__builtin_amdgcn_exp2f(p[gg][rr]-rm); l_reg+=p[gg][rr];}
  { auto sw=__builtin_amdgcn_permlane32_swap(__float_as_uint(l_reg),__float_as_uint(l_reg),false,false); l_reg=__uint_as_float(sw[0])+__uint_as_float(sw[1]); }
  f32x16 o[2]; o[0]=f32x16{}; o[1]=f32x16{};
  #pragma unroll
  for(int gg=0;gg<5;++gg){
    if(wid+gg>=gfirst){
      u32x4 pw0,pw1;
      pw0=(u32x4){cvtpk_s(p[gg][0],p[gg][1]),cvtpk_s(p[gg][2],p[gg][3]),cvtpk_s(p[gg][4],p[gg][5]),cvtpk_s(p[gg][6],p[gg][7])};
      pw1=(u32x4){cvtpk_s(p[gg][8],p[gg][9]),cvtpk_s(p[gg][10],p[gg][11]),cvtpk_s(p[gg][12],p[gg][13]),cvtpk_s(p[gg][14],p[gg][15])};
      const lds_cptr vp=s3+(wid+gg)*GB+4096+((lane>>4)&1)*32+(lane&3)*8+(4*hi+((lane&15)>>2))*64;
      #pragma unroll
      for(int d0=0;d0<2;++d0){
        const s16x4 a0=vtr(vp+d0*2048), a1=vtr(vp+d0*2048+512), c0=vtr(vp+d0*2048+1024), c1=vtr(vp+d0*2048+1536);
        const bf16x8 v0=(bf16x8){a0[0],a0[1],a0[2],a0[3],a1[0],a1[1],a1[2],a1[3]}, v1=(bf16x8){c0[0],c0[1],c0[2],c0[3],c1[0],c1[1],c1[2],c1[3]};
        o[d0]=__builtin_amdgcn_mfma_f32_32x32x16_bf16(__builtin_bit_cast(bf16x8,pw0),v0,o[d0],0,0,0);
        o[d0]=__builtin_amdgcn_mfma_f32_32x32x16_bf16(__builtin_bit_cast(bf16x8,pw1),v1,o[d0],0,0,0); } } }
  if(hi==0){ wsf[r32]=l_reg; LSE[(size_t)(rowbase+tq)*8+h]=rm+__builtin_amdgcn_logf(l_reg); }
  asm volatile("s_waitcnt lgkmcnt(0)":::"memory");
  float rli[16];
  #pragma unroll
  for(int rr=0;rr<16;++rr)rli[rr]=__builtin_amdgcn_rcpf(wsf[crow(rr,hi)]);
  { bf16*stg=(bf16*)(shm+STG_OFF)+wid*2048;
    #pragma unroll
    for(int rr=0;rr<16;++rr){const int orow=crow(rr,hi);
      #pragma unroll
      for(int d0=0;d0<2;++d0)stg[orow*64+d0*32+r32]=f2bf_s(o[d0][rr]*rli[rr]);}
    asm volatile("s_waitcnt lgkmcnt(0)":::"memory");
    #pragma unroll
    for(int i=0;i<4;++i){const int row=i*8+(lane>>3),c8=lane&7; const u32x4 v=*(const u32x4*)(stg+row*64+c8*8);
      const long grow=rowbase+cl+((long)(j0+32*wid+row)<<sh);
      *(DGAS u32x4*)(Pout+grow*512+h*64+c8*8)=v; } }
  asm volatile("s_waitcnt lgkmcnt(0)\n\ts_barrier":::"memory");
}
__device__ __forceinline__ void dil_combine_row(long row,int lane,DGAS const bf16*Pout,DGAS const float*LSE,size_t pstride,size_t lstride,DGAS bf16*O,DGAS float*ss){
  const int head=lane>>3;
  const float l0=LSE[(size_t)row*8+head], l1=LSE[lstride+(size_t)row*8+head], l2=LSE[2*lstride+(size_t)row*8+head];
  const float mx=__builtin_fmaxf(__builtin_fmaxf(l0,l1),l2);
  float w0=__builtin_amdgcn_exp2f(l0-mx), w1=__builtin_amdgcn_exp2f(l1-mx), w2=__builtin_amdgcn_exp2f(l2-mx); const float iw=1.0f/(w0+w1+w2); w0*=iw; w1*=iw; w2*=iw;
  const u32x4 a=*(DGAS const u32x4*)(Pout+(size_t)row*512+lane*8), c=*(DGAS const u32x4*)(Pout+pstride+(size_t)row*512+lane*8), e=*(DGAS const u32x4*)(Pout+2*pstride+(size_t)row*512+lane*8);
  u32x4 outv; float sq=0.f;
  #pragma unroll
  for(int i=0;i<4;++i){
    const float lo=w0*__builtin_bit_cast(float,a[i]<<16)+w1*__builtin_bit_cast(float,c[i]<<16)+w2*__builtin_bit_cast(float,e[i]<<16);
    const float hi2=w0*__builtin_bit_cast(float,a[i]&0xffff0000u)+w1*__builtin_bit_cast(float,c[i]&0xffff0000u)+w2*__builtin_bit_cast(float,e[i]&0xffff0000u);
    const unsigned pk=cvtpk_s(lo,hi2); outv[i]=pk;
    const float rl=__builtin_bit_cast(float,pk<<16), rh=__builtin_bit_cast(float,pk&0xffff0000u); sq+=rl*rl+rh*rh; }
  *(DGAS u32x4*)(O+(size_t)row*1024+512+lane*8)=outv;
  sq+=__shfl_xor(sq,1); sq+=__shfl_xor(sq,2); sq+=__shfl_xor(sq,4);
  if((lane&7)==0) ss[(size_t)row*16+8+head]=sq;
}
}

namespace dil3 {
using attn_body::bf16x8; using attn_body::s16x4; using attn_body::f32x16; using attn_body::u32x4; using attn_body::bf16; using attn_body::lds_cptr;
using attn_body::crow; using attn_body::glds16; using attn_body::vtr; using attn_body::cvtpk_s; using attn_body::f2bf_s;
constexpr int KREG=0, VREG=49152, QREG=98304, RING_END=131072;
#define DGAS __attribute__((address_space(1)))
#define DLAS __attribute__((address_space(3)))
struct UnitP { int b,h,cfg,cl,ch; };
__device__ __forceinline__ UnitP unit_of(int i,int G,int vcu){ int bh,u; if(G==256){bh=vcu>>3;u=(vcu&7)+8*i;}else{const int it=vcu+i*G;bh=it/48;u=it%48;}
  UnitP p; p.b=bh>>3; p.h=bh&7; p.cfg=u>>4; p.cl=(p.cfg==0)?0:(p.cfg==1?((u-16)>>2):(u-32)); p.ch=(p.cfg==0)?u:(p.cfg==1?((u-16)&3):0); return p; }
__device__ __forceinline__ void dil_phase(int hotmask,int nun,int G,int vcu,int SEQL,DGAS const bf16*Q,DGAS const bf16*K,DGAS const bf16*V,DGAS bf16*Pout,size_t pstride,DGAS float*LSE,size_t lstride,char*shm,char*ostg,float*wsf,const int wid){
  if(nun<=0)return;
  int lane_; asm volatile("v_mbcnt_lo_u32_b32 %0, -1, 0\n\tv_mbcnt_hi_u32_b32 %0, -1, %0":"=v"(lane_));
  const int lane=lane_,r32=lane&31,hi=lane>>5;
  const unsigned lds0=(unsigned)(uintptr_t)shm; const lds_cptr s3=(lds_cptr)shm;
  #define CLAMPJ(j) ((j)<0?0:(j))
  #define ISSUE_K(P) do{ const int sh_=2*(P).cfg, j0_=256*(P).ch; DGAS const bf16*Kh_=K+((long)(P).b*SEQL)*1024+512+(P).h*64; \
      _Pragma("unroll") for(int k_=0;k_<6;++k_){ const int n_=wid*6+k_, g_=n_>>2, c_=n_&3; \
        const int tk_=((P).cl+(CLAMPJ(j0_-128+32*g_+(lane&31))<<sh_))&hotmask; \
        glds16((const void*)(Kh_+(long)tk_*1024+(2*c_+(lane>>5))*8),(unsigned)__builtin_amdgcn_readfirstlane(lds0+KREG+g_*4096+c_*1024)); } }while(0)
  #define ISSUE_V(P) do{ const int sh_=2*(P).cfg, j0_=256*(P).ch; DGAS const bf16*Vh_=V+((long)(P).b*SEQL)*1024+512+(P).h*64; \
      _Pragma("unroll") for(int k_=0;k_<6;++k_){ const int n_=wid*6+k_, g_=n_>>2, c_=n_&3; \
        const int tk_=((P).cl+(CLAMPJ(j0_-128+32*g_+16*(c_&1)+(lane>>2))<<sh_))&hotmask; \
        glds16((const void*)(Vh_+(long)tk_*1024+(c_>>1)*32+(lane&3)*8),(unsigned)__builtin_amdgcn_readfirstlane(lds0+VREG+g_*4096+c_*1024)); } }while(0)
  #define ISSUE_Q(P) do{ const int sh_=2*(P).cfg, j0_=256*(P).ch; DGAS const bf16*Qh_=Q+((long)(P).b*SEQL)*1024+512+(P).h*64; \
      const int tq_=(P).cl+((j0_+32*wid+(lane&31))<<sh_); \
      _Pragma("unroll") for(int c_=0;c_<4;++c_) glds16((const void*)(Qh_+(long)tq_*1024+(2*c_+(lane>>5))*8),(unsigned)__builtin_amdgcn_readfirstlane(lds0+QREG+wid*4096+c_*1024)); }while(0)
  UnitP cur=unit_of(0,G,vcu);
  ISSUE_K(cur); ISSUE_Q(cur);
  #pragma nounroll
  for(int ui=0;ui<nun;++ui){
    const bool has_next=(ui+1<nun); const UnitP nxt=has_next?unit_of(ui+1,G,vcu):cur;
    const int sh=2*cur.cfg, j0=256*cur.ch; const long rowbase=(long)cur.b*SEQL; const int gfirst=(cur.ch==0)?4:0;
    asm volatile("s_waitcnt vmcnt(0) lgkmcnt(0)\n\ts_barrier":::"memory");
    ISSUE_V(cur);
    bf16x8 qr[4];
    { const lds_cptr qp=s3+QREG+wid*4096+hi*512+r32*16;
      qr[0]=*(DLAS const bf16x8*)(qp); qr[1]=*(DLAS const bf16x8*)(qp+1024); qr[2]=*(DLAS const bf16x8*)(qp+2048); qr[3]=*(DLAS const bf16x8*)(qp+3072); }
    f32x16 p[5];
    #pragma unroll
    for(int gg=0;gg<5;++gg){
      const lds_cptr kp=s3+KREG+(wid+gg)*4096+hi*512+r32*16;
      const bf16x8 k0=*(DLAS const bf16x8*)(kp), k1=*(DLAS const bf16x8*)(kp+1024), k2=*(DLAS const bf16x8*)(kp+2048), k3=*(DLAS const bf16x8*)(kp+3072);
      f32x16 a=f32x16{};
      a=__builtin_amdgcn_mfma_f32_32x32x16_bf16(k0,qr[0],a,0,0,0); a=__builtin_amdgcn_mfma_f32_32x32x16_bf16(k1,qr[1],a,0,0,0);
      a=__builtin_amdgcn_mfma_f32_32x32x16_bf16(k2,qr[2],a,0,0,0); a=__builtin_amdgcn_mfma_f32_32x32x16_bf16(k3,qr[3],a,0,0,0);
      p[gg]=a; }
    asm volatile("s_waitcnt lgkmcnt(0)\n\ts_barrier":::"memory");
    if(has_next){ ISSUE_K(nxt); ISSUE_Q(nxt); }
    #pragma unroll
    for(int gg=0;gg<4;++gg){ if(wid+gg<gfirst){
      #pragma unroll
      for(int rr=0;rr<16;++rr)p[gg][rr]=-INFINITY; } }
    #pragma unroll
    for(int rr=0;rr<16;++rr){ const int kk=crow(rr,hi); if(kk<r32)p[0][rr]=-INFINITY; if(kk>r32)p[4][rr]=-INFINITY; }
    float rm=p[0][0];
    #pragma unroll
    for(int gg=0;gg<5;++gg)
      #pragma unroll
      for(int rr=0;rr<16;++rr)rm=__builtin_fmaxf(rm,p[gg][rr]);
    { auto sw=__builtin_amdgcn_permlane32_swap(__float_as_uint(rm),__float_as_uint(rm),false,false); rm=__builtin_fmaxf(__uint_as_float(sw[0]),__uint_as_float(sw[1])); }
    float l_reg=0.f;
    #pragma unroll
    for(int gg=0;gg<5;++gg)
      #pragma unroll
      for(int rr=0;rr<16;++rr){p[gg][rr]=__builtin_amdgcn_exp2f(p[gg][rr]-rm); l_reg+=p[gg][rr];}
    { auto sw=__builtin_amdgcn_permlane32_swap(__float_as_uint(l_reg),__float_as_uint(l_reg),false,false); l_reg=__uint_as_float(sw[0])+__uint_as_float(sw[1]); }
    if(has_next) asm volatile("s_waitcnt vmcnt(10)\n\ts_barrier":::"memory"); else asm volatile("s_waitcnt vmcnt(0)\n\ts_barrier":::"memory");
    f32x16 o[2]; o[0]=f32x16{}; o[1]=f32x16{};
    #pragma unroll
    for(int gg=0;gg<5;++gg){
      u32x4 pw0,pw1;
      pw0=(u32x4){cvtpk_s(p[gg][0],p[gg][1]),cvtpk_s(p[gg][2],p[gg][3]),cvtpk_s(p[gg][4],p[gg][5]),cvtpk_s(p[gg][6],p[gg][7])};
      pw1=(u32x4){cvtpk_s(p[gg][8],p[gg][9]),cvtpk_s(p[gg][10],p[gg][11]),cvtpk_s(p[gg][12],p[gg][13]),cvtpk_s(p[gg][14],p[gg][15])};
      const lds_cptr vp=s3+VREG+(wid+gg)*4096+((lane>>4)&1)*32+(lane&3)*8+(4*hi+((lane&15)>>2))*64;
      #pragma unroll
      for(int d0=0;d0<2;++d0){
        const s16x4 a0=vtr(vp+d0*2048), a1=vtr(vp+d0*2048+512), c0=vtr(vp+d0*2048+1024), c1=vtr(vp+d0*2048+1536);
        const bf16x8 v0=(bf16x8){a0[0],a0[1],a0[2],a0[3],a1[0],a1[1],a1[2],a1[3]}, v1=(bf16x8){c0[0],c0[1],c0[2],c0[3],c1[0],c1[1],c1[2],c1[3]};
        o[d0]=__builtin_amdgcn_mfma_f32_32x32x16_bf16(__builtin_bit_cast(bf16x8,pw0),v0,o[d0],0,0,0);
        o[d0]=__builtin_amdgcn_mfma_f32_32x32x16_bf16(__builtin_bit_cast(bf16x8,pw1),v1,o[d0],0,0,0); } }
    const int tq=cur.cl+((j0+32*wid+r32)<<sh);
    DGAS bf16*Pc=Pout+(size_t)cur.cfg*pstride; DGAS float*Lc=LSE+(size_t)cur.cfg*lstride;
    if(hi==0){ wsf[r32]=l_reg; Lc[(size_t)(rowbase+tq)*8+cur.h]=rm+__builtin_amdgcn_logf(l_reg); }
    asm volatile("s_waitcnt lgkmcnt(0)":::"memory");
    float rli[16];
    #pragma unroll
    for(int rr=0;rr<16;++rr)rli[rr]=__builtin_amdgcn_rcpf(wsf[crow(rr,hi)]);
    bf16*stg=(bf16*)ostg+wid*1024;
    #pragma unroll
    for(int ps=0;ps<2;++ps){
      #pragma unroll
      for(int r8=0;r8<8;++r8){ const int rr=8*ps+r8; const int orow=crow(r8,hi);
        #pragma unroll
        for(int d0=0;d0<2;++d0)stg[orow*64+d0*32+r32]=f2bf_s(o[d0][rr]*rli[rr]);}
      asm volatile("s_waitcnt lgkmcnt(0)":::"memory");
      #pragma unroll
      for(int i=0;i<2;++i){const int row=i*8+(lane>>3),c8=lane&7; const u32x4 v=*(const u32x4*)(stg+row*64+c8*8);
        const long grow=rowbase+cur.cl+((long)(j0+32*wid+16*ps+row)<<sh);
        *(DGAS u32x4*)(Pc+grow*512+cur.h*64+c8*8)=v; }
      asm volatile("s_waitcnt lgkmcnt(0)":::"memory"); }
    cur=nxt;
  }
  asm volatile("s_waitcnt vmcnt(0) lgkmcnt(0)\n\ts_barrier":::"memory");
  #undef CLAMPJ
  #undef ISSUE_K
  #undef ISSUE_V
  #undef ISSUE_Q
}
}

constexpr int NWAVES = 8;
constexpr size_t MiB = 1u << 20;
constexpr size_t WS_CTL = 0, CTL_ZERO_BYTES = 64 * 1024;
constexpr size_t WS_CS = 1 * MiB;
constexpr size_t WS_STA = 2 * MiB, WS_STB = 3 * MiB;
constexpr size_t WS_SS = 4 * MiB;
constexpr size_t WS_KM = 5 * MiB;
constexpr size_t WS_W = 8 * MiB, W_BUF = 24 * MiB;
constexpr size_t W_QKV = 0, W_O = 6 * MiB, W_UP = 8 * MiB, W_DN = 16 * MiB;
constexpr size_t WS_XB = 56 * MiB;
constexpr size_t WS_QO = 88 * MiB, WS_KB = 120 * MiB, WS_VB = 152 * MiB;
constexpr size_t WS_H = 88 * MiB;
constexpr size_t WS_PD = 184 * MiB, PD_STRIDE = (size_t)M * 512;
constexpr size_t WS_LSE = 232 * MiB, LSE_STRIDE = (size_t)M * 8;
constexpr size_t WS_END = 234 * MiB;
constexpr int CW_BAR = 1024;

constexpr int RING_BYTES = 131072, LDSCTL_OFF = RING_BYTES, MISC_OFF = LDSCTL_OFF + 320, LDS_BYTES = 155648;

#define GAS __attribute__((address_space(1)))
#define LAS __attribute__((address_space(3)))
typedef unsigned short bf16;
typedef unsigned v4u __attribute__((ext_vector_type(4)));
typedef unsigned v2u __attribute__((ext_vector_type(2)));
typedef float f32x4 __attribute__((ext_vector_type(4)));
typedef GAS unsigned gu32;
#define LDS_WAIT() asm volatile("s_waitcnt lgkmcnt(0)" ::: "memory")
__device__ __forceinline__ unsigned f2bf(float f) { unsigned u = __builtin_bit_cast(unsigned, f); return (u + 0x7fffu + ((u >> 16) & 1u)) >> 16; }
__device__ __forceinline__ unsigned pk2(float lo, float hi) { return f2bf(lo) | (f2bf(hi) << 16); }
__device__ __forceinline__ float bf2f(unsigned h) { return __builtin_bit_cast(float, h << 16); }
__device__ __forceinline__ float wave_sum(float v) {
#pragma unroll
    for (int o = 1; o < 64; o <<= 1) v += __shfl_xor(v, o);
    return v;
}
__device__ __forceinline__ float wave_max(float v) {
#pragma unroll
    for (int o = 1; o < 64; o <<= 1) v = fmaxf(v, __shfl_xor(v, o));
    return v;
}

#define XB_TMO      128
#define XB_XCNT(j)  (256  + 64 * (j))
#define XB_XSUB(j)  (1280 + 64 * (j))
#define XB_XGEN(j)  (2304 + 64 * (j))
#define XB_TOP      3328
#define XB_TOPGEN   3392
#define XCD_BAR_WORDS 3456
#define XB_SPIN_CAP (1u << 18)
__device__ __forceinline__ unsigned xb_ld(unsigned* p)              { return __hip_atomic_load(p, __ATOMIC_RELAXED, __HIP_MEMORY_SCOPE_AGENT); }
__device__ __forceinline__ unsigned xb_add(unsigned* p, unsigned v) { return __hip_atomic_fetch_add(p, v, __ATOMIC_RELAXED, __HIP_MEMORY_SCOPE_AGENT); }
__device__ __forceinline__ unsigned xb_xcc_id() { return (unsigned)__builtin_amdgcn_s_getreg((3 << 11) | 20) & 0xFu; }
#define XB_SPIN(cond, bar) do { unsigned _sp = 0; while (cond) { __builtin_amdgcn_s_sleep(1); \
    if ((++_sp & 255u) == 0u) { if (xb_ld(&(bar)[XB_TMO])) break; if (_sp > XB_SPIN_CAP) { atomicAdd(&(bar)[XB_TMO], 1u); break; } } } } while (0)
struct XcdBarrier { unsigned* bar; unsigned x; volatile LAS unsigned* st; };
__device__ __forceinline__ XcdBarrier xcd_barrier_post(unsigned* bar, volatile LAS unsigned* st) {
    XcdBarrier b; b.bar = bar; b.x = xb_xcc_id(); b.st = st;
    if (threadIdx.x == 0) (void)xb_add(&bar[XB_XCNT(b.x)], 1u);
    return b;
}
__device__ __forceinline__ void xcd_barrier_complete(unsigned* bar, unsigned x, unsigned& nloc, unsigned& nx) {
    const unsigned G = gridDim.x * gridDim.y * gridDim.z;
    unsigned sum, cnt, mine, sp = 0u;
    for (;;) {
        sum = 0u; cnt = 0u; mine = 0u;
#pragma unroll
        for (unsigned j = 0; j < 16; ++j) { const unsigned c = xb_ld(&bar[XB_XCNT(j)]); sum += c; cnt += (c > 0u) ? 1u : 0u; mine = (j == x) ? c : mine; }
        if (sum == G) break;
        __builtin_amdgcn_s_sleep(1);
        if ((++sp & 255u) == 0u) { if (xb_ld(&bar[XB_TMO])) break; if (sp > XB_SPIN_CAP) { atomicAdd(&bar[XB_TMO], 1u); break; } }
    }
    nloc = mine > 0u ? mine : 1u; nx = cnt > 0u ? cnt : 1u;
}
__device__ __forceinline__ void xcd_barrier(const XcdBarrier& b) {
    asm volatile("s_waitcnt vmcnt(0)" ::: "memory");
    __syncthreads();
    if (threadIdx.x == 0) {
        unsigned* bar = b.bar;
        __builtin_amdgcn_s_waitcnt(0);
        unsigned nloc = b.st[0], nx = b.st[1];
        if (nloc == 0u) { xcd_barrier_complete(bar, b.x, nloc, nx); b.st[0] = nloc; b.st[1] = nx; }
        const unsigned old = xb_add(&bar[XB_XSUB(b.x)], 1u);
        const unsigned gen = old / nloc;
        if (old + 1u == (gen + 1u) * nloc) {
            __builtin_amdgcn_fence(__ATOMIC_RELEASE, "agent");
            asm volatile("s_waitcnt vmcnt(0)" ::: "memory");
            const unsigned og = xb_add(&bar[XB_TOP], 1u);
            const unsigned tg = og / nx;
            if (og + 1u == (tg + 1u) * nx) xb_add(&bar[XB_TOPGEN], 1u);
            else XB_SPIN(xb_ld(&bar[XB_TOPGEN]) == tg, bar);
            __builtin_amdgcn_fence(__ATOMIC_ACQUIRE, "agent");
            xb_add(&bar[XB_XGEN(b.x)], 1u);
            asm volatile("s_waitcnt vmcnt(0)" ::: "memory");
        } else {
            XB_SPIN(xb_ld(&bar[XB_XGEN(b.x)]) == gen, bar);
            __builtin_amdgcn_fence(__ATOMIC_ACQUIRE, "agent");
            asm volatile("s_waitcnt vmcnt(0)" ::: "memory");
        }
    }
    __syncthreads();
}

__device__ __forceinline__ void transpose_item(GAS const float* W, int K, int N, GAS const float* gA, GAS const float* gB, int ksplit, GAS bf16* WT, int k0, int nsrc0, int ndst0, LAS float* scr, int lane) {
    float v[32];
    GAS const float* src = W + (size_t)(k0 + (lane >> 5)) * N + nsrc0 + (lane & 31);
#pragma unroll
    for (int i = 0; i < 32; ++i) v[i] = src[(size_t)(2 * i) * N];
    float g0 = 1.0f, g1 = 1.0f;
    if (gA) { const int k = k0 + lane; g0 = (k < ksplit) ? gA[k] : gB[k - ksplit]; } (void)g1;
#pragma unroll
    for (int i = 0; i < 32; ++i) { const int kk = 2 * i + (lane >> 5); const float g = __shfl(g0, kk); scr[kk * 33 + (lane & 31)] = v[i] * g; }
    LDS_WAIT(); asm volatile("" ::: "memory");
    const int c = lane & 7;
#pragma unroll
    for (int j = 0; j < 4; ++j) { const int n = (lane >> 3) + 8 * j; const LAS float* s = scr + (8 * c) * 33 + n;
        v4u o; o.x = pk2(s[0 * 33], s[1 * 33]); o.y = pk2(s[2 * 33], s[3 * 33]); o.z = pk2(s[4 * 33], s[5 * 33]); o.w = pk2(s[6 * 33], s[7 * 33]);
        *(GAS v4u*)(WT + (size_t)(ndst0 + n) * K + k0 + 8 * c) = o; }
    LDS_WAIT(); asm volatile("" ::: "memory");
}
__device__ __forceinline__ int qkv_src_col(int c) {
    const int pn = c >> 8, p = c & 255, tl = 64 * ((p >> 5) & 3) + 32 * (p >> 7), j = 256 * (pn & 3) + tl, a = pn >> 2;
    return (j < 512) ? (a * 512 + j) : (1536 + a * 512 + (j - 512));
}
struct LayerW { GAS const float *attn_norm, *w_in, *moba_norm, *dil_norm, *w_out, *mlp_norm, *w_up, *w_down; };
__device__ __forceinline__ void convert_layer(const LayerW& L, GAS unsigned char* wb, LAS float* scr, int gw, int NGW, int lane) {
    constexpr int I_QKV = (DM / 64) * (NQKV / 32), I_O = (DM / 64) * (DM / 32), I_UP = (DM / 64) * (DFF / 32), I_DN = (DFF / 64) * (DM / 32);
    for (int it = gw; it < I_QKV + I_O + I_UP + I_DN; it += NGW) {
        int r = it; GAS const float* W; GAS const float* gA; GAS const float* gB; int K, N, ksplit, nb, kb, nsrc; GAS bf16* WT;
        if (r < I_QKV) { nb = r % (NQKV / 32); kb = r / (NQKV / 32); W = L.w_in; K = DM; N = NQKV; gA = L.attn_norm; gB = L.attn_norm; ksplit = DM; WT = (GAS bf16*)(wb + W_QKV); nsrc = qkv_src_col(32 * nb); }
        else if (r < I_QKV + I_O) { r -= I_QKV; nb = r % (DM / 32); kb = r / (DM / 32); W = L.w_out; K = DM; N = DM; gA = L.moba_norm; gB = L.dil_norm; ksplit = 512; WT = (GAS bf16*)(wb + W_O); nsrc = 32 * nb; }
        else if (r < I_QKV + I_O + I_UP) { r -= I_QKV + I_O; nb = r % (DFF / 32); kb = r / (DFF / 32); W = L.w_up; K = DM; N = DFF; gA = L.mlp_norm; gB = L.mlp_norm; ksplit = DM; WT = (GAS bf16*)(wb + W_UP); nsrc = 32 * nb; }
        else { r -= I_QKV + I_O + I_UP; nb = r % (DM / 32); kb = r / (DM / 32); W = L.w_down; K = DFF; N = DM; gA = nullptr; gB = nullptr; ksplit = 0; WT = (GAS bf16*)(wb + W_DN); nsrc = 32 * nb; }
        transpose_item(W, K, N, gA, gB, ksplit, WT, 64 * kb, nsrc, 32 * nb, scr, lane);
    }
}

#define KEY_UPDATE(krow, vrow, valid)                                                                                   \
    do {                                                                                                                \
        if (valid) {                                                                                                    \
            float s = 0.f;                                                                                              \
            _Pragma("unroll") for (int c = 0; c < 8; ++c) {                                                             \
                const v4u kk = ((GAS const v4u*)(krow))[c];                                                             \
                s += qv[8 * c + 0] * bf2f(kk.x & 0xffffu) + qv[8 * c + 1] * bf2f(kk.x >> 16) + qv[8 * c + 2] * bf2f(kk.y & 0xffffu) + qv[8 * c + 3] * bf2f(kk.y >> 16) \
                   + qv[8 * c + 4] * bf2f(kk.z & 0xffffu) + qv[8 * c + 5] * bf2f(kk.z >> 16) + qv[8 * c + 6] * bf2f(kk.w & 0xffffu) + qv[8 * c + 7] * bf2f(kk.w >> 16); \
            }                                                                                                           \
            if (s > mrun) { const float f = exp2f(mrun - s); lrun *= f; _Pragma("unroll") for (int d = 0; d < 64; ++d) ov[d] *= f; mrun = s; } \
            const float p = exp2f(s - mrun); lrun += p;                                                                 \
            _Pragma("unroll") for (int c = 0; c < 8; ++c) {                                                             \
                const v4u vv = ((GAS const v4u*)(vrow))[c];                                                             \
                ov[8 * c + 0] += p * bf2f(vv.x & 0xffffu); ov[8 * c + 1] += p * bf2f(vv.x >> 16); ov[8 * c + 2] += p * bf2f(vv.y & 0xffffu); ov[8 * c + 3] += p * bf2f(vv.y >> 16); \
                ov[8 * c + 4] += p * bf2f(vv.z & 0xffffu); ov[8 * c + 5] += p * bf2f(vv.z >> 16); ov[8 * c + 6] += p * bf2f(vv.w & 0xffffu); ov[8 * c + 7] += p * bf2f(vv.w >> 16); \
            }                                                                                                           \
        }                                                                                                               \
    } while (0)
#define WAVE_FINISH(orow, ssptr)                                                                                        \
    do {                                                                                                                \
        const float mall = wave_max(mrun);                                                                              \
        const float f = (mrun > -1e37f) ? exp2f(mrun - mall) : 0.f;                                                     \
        const float ltot = wave_sum(lrun * f); const float il = 1.0f / ltot;                                            \
        float mine = 0.f, sq = 0.f;                                                                                     \
        _Pragma("unroll") for (int d = 0; d < 64; ++d) { const float od = wave_sum(ov[d] * f) * il; sq += od * od; if (lane == d) mine = od; } \
        (orow)[lane] = (bf16)f2bf(mine);                                                                                \
        if (lane == 0) *(ssptr) = sq;                                                                                   \
    } while (0)
#define LOAD_Q(qptr)                                                                                                    \
    float qv[64];                                                                                                       \
    { GAS const v4u* qp = (GAS const v4u*)(qptr);                                                                           \
      _Pragma("unroll") for (int c = 0; c < 8; ++c) { const v4u u = qp[c];                                            \
        qv[8 * c + 0] = bf2f(u.x & 0xffffu); qv[8 * c + 1] = bf2f(u.x >> 16); qv[8 * c + 2] = bf2f(u.y & 0xffffu); qv[8 * c + 3] = bf2f(u.y >> 16); \
        qv[8 * c + 4] = bf2f(u.z & 0xffffu); qv[8 * c + 5] = bf2f(u.z >> 16); qv[8 * c + 6] = bf2f(u.w & 0xffffu); qv[8 * c + 7] = bf2f(u.w >> 16); } }

__device__ __forceinline__ void moba_naive_one(int w, int lane, GAS bf16* QO, GAS const bf16* KB, GAS const bf16* VB, GAS const float* kmean, GAS float* ss) {
    const int t = w & (SEQ - 1), h = (w >> 12) & 7, b = w >> 15, m = b * SEQ + t, qb = t >> 8;
    LOAD_Q(QO + (size_t)m * DM + h * 64);
    float gj;
    { const int j = lane & 15; GAS const f32x4* kmp = (GAS const f32x4*)(kmean + (size_t)((b * 8 + h) * 16 + j) * 64);
      float s = 0.f;
#pragma unroll
      for (int c = 0; c < 16; ++c) { const f32x4 k4 = kmp[c]; s += qv[4 * c] * k4.x + qv[4 * c + 1] * k4.y + qv[4 * c + 2] * k4.z + qv[4 * c + 3] * k4.w; }
      gj = (j < qb) ? s : -1e30f; }
    unsigned sel = 0u;
#pragma unroll
    for (int r = 0; r < 3; ++r) {
        float best = -INFINITY; int bi = 0;
#pragma unroll
        for (int jj = 0; jj < 16; ++jj) { const float v = __shfl(gj, jj); const bool ok = !((sel >> jj) & 1u); if (ok && v > best) { best = v; bi = jj; } }
        sel |= 1u << bi;
    }
    sel &= (1u << qb) - 1u; sel |= 1u << qb;
    float ov[64]; float mrun = -INFINITY, lrun = 0.f;
#pragma unroll
    for (int d = 0; d < 64; ++d) ov[d] = 0.f;
    GAS const bf16* kbase = KB + (size_t)(b * SEQ) * DM + h * 64; GAS const bf16* vbase = VB + (size_t)(b * SEQ) * DM + h * 64;
    for (int jb = 0; jb <= qb; ++jb) {
        if (!((sel >> jb) & 1u)) continue;
        for (int i = 0; i < 4; ++i) { const int key = jb * 256 + i * 64 + lane; const bool valid = key <= t; KEY_UPDATE(kbase + (size_t)key * DM, vbase + (size_t)key * DM, valid); }
    }
    WAVE_FINISH(QO + (size_t)m * DM + h * 64, ss + (size_t)m * 16 + h);
}
__device__ __forceinline__ void dil_naive_one(int w, int lane, GAS bf16* QO, GAS const bf16* KB, GAS const bf16* VB, GAS float* ss) {
    const int t = w & (SEQ - 1), h = (w >> 12) & 7, b = w >> 15, m = b * SEQ + t;
    LOAD_Q(QO + (size_t)m * DM + 512 + h * 64);
    float ov[64]; float mrun = -INFINITY, lrun = 0.f;
#pragma unroll
    for (int d = 0; d < 64; ++d) ov[d] = 0.f;
    GAS const bf16* kbase = KB + (size_t)(b * SEQ) * DM + 512 + h * 64; GAS const bf16* vbase = VB + (size_t)(b * SEQ) * DM + 512 + h * 64;
    for (int cfg = 0; cfg < 3; ++cfg) {
        const int dil = cfg == 0 ? 1 : (cfg == 1 ? 4 : 16);
        for (int i = 0; i < 3; ++i) { const int n = i * 64 + lane; const int key = t - dil * n; const bool valid = (n < 129) && (key >= 0); const int keyc = key < 0 ? 0 : key;
            KEY_UPDATE(kbase + (size_t)keyc * DM, vbase + (size_t)keyc * DM, valid); }
    }
    WAVE_FINISH(QO + (size_t)m * DM + 512 + h * 64, ss + (size_t)m * 16 + 8 + h);
}

struct Args { const float* in[10]; float* out; unsigned char* ws; int ph_lo, ph_hi, li, pad; };
constexpr int PH_PER_LAYER = 6, N_PHASES = 1 + DEPTH * PH_PER_LAYER + 1;
typedef GAS float gf32; typedef GAS const float gcf32; typedef GAS bf16 gbf16; typedef GAS f32x4 gf32x4; typedef GAS const f32x4 gcf32x4;

__global__ void __launch_bounds__(NWAVES * 64, 2) fwd_kernel(Args args) {
    extern __shared__ __attribute__((aligned(16))) unsigned char lds[];
    LAS unsigned char* L = (LAS unsigned char*)lds;
    volatile LAS unsigned* MISC = (volatile LAS unsigned*)(L + MISC_OFF);
    const int G = gridDim.x; const int bx = blockIdx.x;
    const int wave_s = __builtin_amdgcn_readfirstlane(threadIdx.x >> 6);
    gu32* ctl = (gu32*)(args.ws + WS_CTL);
    for (int u = threadIdx.x; u < (LDS_BYTES - LDSCTL_OFF) / 4; u += NWAVES * 64) ((LAS unsigned*)(L + LDSCTL_OFF))[u] = 0u;
    __syncthreads();
    XcdBarrier bar; bar.bar = (unsigned*)(ctl + CW_BAR) + args.li * XCD_BAR_WORDS; bar.x = 0; bar.st = nullptr;
    if (!MK_PER_PHASE) bar = xcd_barrier_post((unsigned*)(ctl + CW_BAR) + args.li * XCD_BAR_WORDS, MISC + 8);
    const int lo = args.ph_lo, hi = args.ph_hi; (void)lo; (void)hi;
#define IN(k) (lo <= (k) && (k) < hi)
#define SEAM(k) do { if (IN(k) && IN((k) + 1)) { xcd_barrier(bar); if (PROBE_PHASE == 6) xcd_barrier(bar); } } while (0)
#define OPAQUE_S(p) asm volatile("" : "+s"(p))
#define PHASE_IDS() \
    int lane_; asm volatile("v_mbcnt_lo_u32_b32 %0, -1, 0\n\tv_mbcnt_hi_u32_b32 %0, -1, %0" : "=v"(lane_)); const int lane = lane_, wave = wave_s, tid = wave * 64 + lane; (void)tid; \
    const int vcu = (G % 8 == 0) ? (bx % 8) * (G / 8) + bx / 8 : bx; const int gw = vcu * NWAVES + wave, NGW = G * NWAVES; (void)lane; (void)gw; (void)NGW
#define PHASE_PTRS() \
    unsigned char* ws_ = args.ws; OPAQUE_S(ws_); GAS unsigned char* ws = (GAS unsigned char*)ws_; float* xres_ = args.out; OPAQUE_S(xres_); gf32* xres = (gf32*)xres_; \
    gf32* cs = (gf32*)(ws + WS_CS); gf32* stA = (gf32*)(ws + WS_STA); gf32* stB = (gf32*)(ws + WS_STB); gf32* ss = (gf32*)(ws + WS_SS); gf32* kmean = (gf32*)(ws + WS_KM); \
    gbf16* xb = (gbf16*)(ws + WS_XB); gbf16* QO = (gbf16*)(ws + WS_QO); gbf16* KB = (gbf16*)(ws + WS_KB); gbf16* VB = (gbf16*)(ws + WS_VB); gbf16* HB = (gbf16*)(ws + WS_H); \
    (void)cs; (void)stA; (void)stB; (void)ss; (void)kmean; (void)xb; (void)QO; (void)KB; (void)VB; (void)HB; (void)xres
#define LAYERW(l) LayerW{(gcf32*)args.in[1] + (size_t)(l) * DM, (gcf32*)args.in[2] + (size_t)(l) * DM * NQKV, (gcf32*)args.in[3] + (size_t)(l) * 512, (gcf32*)args.in[4] + (size_t)(l) * 512, \
                         (gcf32*)args.in[5] + (size_t)(l) * DM * DM, (gcf32*)args.in[6] + (size_t)(l) * DM, (gcf32*)args.in[7] + (size_t)(l) * DM * DFF, (gcf32*)args.in[8] + (size_t)(l) * DFF * DM}

    if (IN(0)) {
        PHASE_IDS(); PHASE_PTRS(); gcf32* x_in = (gcf32*)args.in[0];
        LAS float* scr = (LAS float*)(L + wave * 16384);
        for (int idx = bx * (NWAVES * 64) + tid; idx < SEQ * 32; idx += G * NWAVES * 64) {
            const int t = idx >> 5, i = idx & 31;
            const float inv = 1.0f / powf(10000.0f, (float)(2 * i) / 64.0f); const float ang = (float)t * inv;
            typedef _Float16 h2_t __attribute__((ext_vector_type(2)));
            const h2_t hv = {(_Float16)cosf(ang), (_Float16)sinf(ang)};
            ((GAS unsigned*)cs)[idx] = __builtin_bit_cast(unsigned, hv);
        }
        { const LayerW LW = LAYERW(0); convert_layer(LW, ws + WS_W, scr, gw, NGW, lane); }
        for (int row = gw; row < M; row += NGW) {
            gcf32x4* xr = (gcf32x4*)(x_in + (size_t)row * DM); float s = 0.f;
#pragma unroll
            for (int j = 0; j < 4; ++j) { const f32x4 v = xr[lane + 64 * j]; s += (v[0] * v[0] + v[1] * v[1]) + (v[2] * v[2] + v[3] * v[3]);
                v2u o; o.x = pk2(v[0], v[1]); o.y = pk2(v[2], v[3]); ((GAS v2u*)(xb + (size_t)row * DM))[lane + 64 * j] = o; }
            s = wave_sum(s);
            if (lane < 16) stA[(size_t)row * 16 + lane] = (lane == 0) ? s : 0.f;
        }
    }
    SEAM(0);

#pragma nounroll
    for (int l = 0; l < DEPTH; ++l) {
        const int p0 = 1 + l * PH_PER_LAYER;
        if (IN(p0)) {
            PHASE_PTRS(); GAS unsigned char* wb = ws + WS_W + (size_t)(l & 1) * W_BUF;
            pg8::Gemm g{(const bf16*)xb, (const bf16*)(wb + W_QKV), M, NQKV, DM}; pg8::StaticOrder S; S.init(M, NQKV, G, bx);
            pg8::EpiQKV E{QO, (size_t)(WS_KB - WS_QO) / 2, stA, (GAS const unsigned*)cs, kmean};
            if (PROBE_PHASE == 10) { pg8::EpiNull Ed{(gf32*)(ws + 250 * MiB)}; pg8::gemm_phase<pg8::EpiNull, pg8::StaticOrder, true>(L, g, S, Ed, wave_s); }
#pragma nounroll
            for (int rep = 0; rep < (PROBE_PHASE == 0 ? 2 : 1); ++rep)
            pg8::gemm_phase<pg8::EpiQKV, pg8::StaticOrder, true>(L, g, S, E, wave_s);
        }
        SEAM(p0);
        if (IN(p0 + 1)) {
            PHASE_IDS(); PHASE_PTRS();
            LAS float* scr = (LAS float*)(L + wave * 16384);
#pragma nounroll
            for (int rep = 0; rep < (PROBE_PHASE == 1 ? 2 : 1); ++rep)
            if (l + 1 < DEPTH) { const LayerW LW = LAYERW(l + 1); convert_layer(LW, ws + WS_W + (size_t)((l + 1) & 1) * W_BUF, scr, gw, NGW, lane); }
            asm volatile("s_waitcnt vmcnt(0) lgkmcnt(0)\n\ts_barrier" ::: "memory");
            static_assert(dil3::RING_END <= RING_BYTES && RING_BYTES + 4096 + 16384 <= LDS_BYTES, "dilated staging vs LDS map");
            gbf16* Pout = (gbf16*)(ws + WS_PD); gf32* LSE = (gf32*)(ws + WS_LSE);
            float* wsf = (float*)((char*)lds + RING_BYTES + 1024) + wave * 64;
            const int nun = (G == 256) ? 6 : (BATCH * 8 * 48 - vcu + G - 1) / G;
#pragma nounroll
            for (int rep = 0; rep < ((PROBE_PHASE == 7 || PROBE_PHASE == 9) ? 2 : 1); ++rep)
            dil3::dil_phase((PROBE_PHASE == 9 && rep == 0) ? 255 : 0xffff, nun, G, vcu, SEQ, QO, KB, VB, Pout, PD_STRIDE, LSE, LSE_STRIDE, (char*)lds, (char*)lds + RING_BYTES + 4096, wsf, wave);
        }
        SEAM(p0 + 1);
        if (IN(p0 + 2)) {
            PHASE_IDS(); PHASE_PTRS();
            static_assert(attn_body::ATTN_LDS_BYTES <= RING_BYTES, "attention scratch vs LDS ring");
            const int nun = (G == 256) ? 2 : (BATCH * 8 * 16 - vcu + G - 1) / G;
            gbf16* Odum = (gbf16*)(ws + 234 * MiB); gf32* ssdum = (gf32*)(ws + 250 * MiB); (void)Odum; (void)ssdum;
#pragma nounroll
            for (int rep = 0; rep < (PROBE_PHASE == 2 ? 2 : 1); ++rep)
#pragma nounroll
            for (int i = 0; i < nun; ++i) {
                int bh, qb;
                if (G == 256) { bh = vcu >> 3; qb = (i == 0) ? 15 - (vcu & 7) : (vcu & 7); } else { const int u = vcu + i * G; bh = u >> 4; qb = u & 15; }
                const bool dum = (PROBE_PHASE == 2) && rep == 0;
                attn_body::moba_unit<8>(bh >> 3, bh & 7, qb, SEQ, QO, KB, VB, dum ? Odum : QO, kmean, dum ? ssdum : ss, (char*)lds, wave);
            }
            { gbf16* Pout = (gbf16*)(ws + WS_PD); gf32* LSE = (gf32*)(ws + WS_LSE);
              int lane; asm volatile("v_mbcnt_lo_u32_b32 %0, -1, 0\n\tv_mbcnt_hi_u32_b32 %0, -1, %0" : "=v"(lane));
#pragma nounroll
              for (int rep = 0; rep < (PROBE_PHASE == 8 ? 2 : 1); ++rep)
              for (int row = gw; row < M; row += NGW) dil2::dil_combine_row(row, lane, Pout, LSE, PD_STRIDE, LSE_STRIDE, QO, ss); }
        }
        SEAM(p0 + 2);
        if (IN(p0 + 3)) {
            PHASE_PTRS(); GAS unsigned char* wb = ws + WS_W + (size_t)(l & 1) * W_BUF;
            pg8::Gemm g{(const bf16*)QO, (const bf16*)(wb + W_O), M, DM, DM}; pg8::StaticOrder S; S.init(M, DM, G, bx);
            pg8::EpiRes<true> E{xb, stB, ss};
            pg8::gemm_phase<pg8::EpiRes<true>, pg8::StaticOrder, false>(L, g, S, E, wave_s);
        }
        SEAM(p0 + 3);
        if (IN(p0 + 4)) {
            PHASE_PTRS(); GAS unsigned char* wb = ws + WS_W + (size_t)(l & 1) * W_BUF;
            pg8::Gemm g{(const bf16*)xb, (const bf16*)(wb + W_UP), M, DFF, DM}; pg8::StaticOrder S; S.init(M, DFF, G, bx);
            pg8::EpiUp E{HB, stB};
#pragma nounroll
            for (int rep = 0; rep < (PROBE_PHASE == 4 ? 2 : 1); ++rep)
            pg8::gemm_phase<pg8::EpiUp, pg8::StaticOrder, true>(L, g, S, E, wave_s);
        }
        SEAM(p0 + 4);
        if (IN(p0 + 5)) {
            PHASE_PTRS(); GAS unsigned char* wb = ws + WS_W + (size_t)(l & 1) * W_BUF;
            pg8::Gemm g{(const bf16*)HB, (const bf16*)(wb + W_DN), M, DM, DFF}; pg8::StaticOrder S; S.init(M, DM, G, bx);
            pg8::EpiRes<false> E{xb, stA, nullptr};
            pg8::gemm_phase<pg8::EpiRes<false>, pg8::StaticOrder, false>(L, g, S, E, wave_s);
        }
        SEAM(p0 + 5);
    }
    if (IN(N_PHASES - 1)) {
        PHASE_IDS(); PHASE_PTRS(); gcf32* gfin = (gcf32*)args.in[9];
        for (int row = gw; row < M; row += NGW) {
            gf32x4* xr = (gf32x4*)(xres + (size_t)row * DM);
            const float r = pg8::row_rs(stA, row, 1.0f / DM);
#pragma unroll
            for (int j = 0; j < 4; ++j) { const v2u bw = ((GAS const v2u*)(xb + (size_t)row * DM))[lane + 64 * j]; const f32x4 gg = ((gcf32x4*)gfin)[lane + 64 * j];
                const f32x4 v = {bf2f(bw.x & 0xffffu), bf2f(bw.x >> 16), bf2f(bw.y & 0xffffu), bf2f(bw.y >> 16)}; xr[lane + 64 * j] = v * r * gg; }
        }
    }
#undef IN
#undef SEAM
}

extern "C" void kernel_launch(void* const* d_in, const int* in_sizes, int n_in, void* d_out, int out_size, void* d_ws, size_t ws_size, hipStream_t stream) {
    static int grid = 0;
    if (grid == 0) {
        if (n_in != 10 || out_size != M * DM || ws_size < WS_END) { fprintf(stderr, "kernel_launch: unexpected shapes (n_in %d out %d ws %zu)\n", n_in, out_size, ws_size); grid = -1; return; }
        int dev = 0, cus = 0, per_cu = 0;
        if (hipGetDevice(&dev) != hipSuccess || hipDeviceGetAttribute(&cus, hipDeviceAttributeMultiprocessorCount, dev) != hipSuccess) { grid = -1; return; }
        if (hipFuncSetAttribute((const void*)fwd_kernel, hipFuncAttributeMaxDynamicSharedMemorySize, LDS_BYTES) != hipSuccess) { fprintf(stderr, "kernel_launch: hipFuncSetAttribute failed\n"); grid = -1; return; }
        if (hipOccupancyMaxActiveBlocksPerMultiprocessor(&per_cu, (const void*)fwd_kernel, NWAVES * 64, LDS_BYTES) != hipSuccess || per_cu < 1)
            fprintf(stderr, "kernel_launch: note: occupancy query reports %d workgroups per CU\n", per_cu);
        (void)hipGetLastError();
        grid = cus;
    }
    if (grid < 0) return;
    if (hipMemsetAsync((char*)d_ws + WS_CTL, 0, CTL_ZERO_BYTES, stream) != hipSuccess) { fprintf(stderr, "kernel_launch: memset failed\n"); return; }
    Args a{};
    for (int i = 0; i < 10; ++i) a.in[i] = (const float*)d_in[i];
    a.out = (float*)d_out; a.ws = (unsigned char*)d_ws;
#if MK_PER_PHASE
    for (int p = 0; p < N_PHASES; ++p) { a.ph_lo = p; a.ph_hi = p + 1; a.li = 0; hipLaunchKernelGGL(fwd_kernel, dim3(grid), dim3(NWAVES * 64), LDS_BYTES, stream, a); }
#else
    a.ph_lo = 0; a.ph_hi = N_PHASES; a.li = 0;
    hipLaunchKernelGGL(fwd_kernel, dim3(grid), dim3(NWAVES * 64), LDS_BYTES, stream, a);
#endif
    const hipError_t le = hipPeekAtLastError();
    if (le != hipSuccess) fprintf(stderr, "kernel_launch: launch failed: %s\n", hipGetErrorName(le));
}
```
